# Optimizing an MI355X kernel written in HIP

```python
import jax, jax.numpy as jnp
from jax import lax
import numpy as np


D_MODEL = 1024
BATCH = 8
SEQ = 4096
DEPTH = 2

HGRN_HEADS = 4
HGRN_EXPAND = 128
HGRN_HEAD_V = 128
HGRN_KDIM = HGRN_HEADS * HGRN_EXPAND
HGRN_VDIM = HGRN_HEADS * HGRN_HEAD_V
HGRN_CHUNK = 64
MIN_FORGET = 1e-20

MOBA_HEADS = 8
MOBA_HEAD_DIM = 64
MOBA_DIM = MOBA_HEADS * MOBA_HEAD_DIM
MOBA_BLOCK = 256
MOBA_TOPK = 3
MOBA_Q_CHUNK = 32
MASK_VALUE = -1e9

D_FF = 2816
N_BRANCH = 2
NORM_EPS = 1e-6

IN_SIZES = (HGRN_KDIM, HGRN_KDIM, HGRN_VDIM, HGRN_VDIM, MOBA_DIM, MOBA_DIM, MOBA_DIM, N_BRANCH * D_MODEL)
D_IN = int(sum(IN_SIZES))
IN_SPLITS = tuple(int(v) for v in np.cumsum(IN_SIZES)[:-1])

kernel_name = 'hybrid_hgrn2_moba_macaron'


def rmsnorm(x, w):
    xf = x.astype(jnp.float32)
    y = xf * lax.rsqrt(jnp.mean(xf * xf, axis=-1, keepdims=True) + NORM_EPS)
    return (y * w.astype(jnp.float32)).astype(x.dtype)


def swiglu(h, w_gu, w_down):
    gate, up = jnp.split(h @ w_gu, 2, axis=-1)
    return (jax.nn.silu(gate) * up) @ w_down


def alibi_slopes(n_heads):
    return jnp.exp2(-8.0 * jnp.arange(1, n_heads + 1, dtype=jnp.float32) / n_heads)


def hgrn2_mix(q, f_logit, i, g, lower_bound, norm_w):
    B, S, _ = q.shape
    H, dk, dv, C = HGRN_HEADS, HGRN_EXPAND, HGRN_HEAD_V, HGRN_CHUNK
    NC = S // C
    qf = jax.nn.silu(q.astype(jnp.float32))
    fl = f_logit.astype(jnp.float32)
    lb = jnp.clip(lower_bound.astype(jnp.float32), 0.0, 1.0)
    sig = jax.nn.sigmoid(fl)
    f = lb + (1.0 - lb) * sig
    log_f = jnp.log(jnp.maximum(f, MIN_FORGET))
    kf = (1.0 - lb) * (1.0 - sig)
    inp = i.astype(jnp.float32)

    def to_chunks(t, hd):
        return t.reshape(B, NC, C, H, hd).transpose(1, 0, 3, 2, 4)

    causal = jnp.tril(jnp.ones((C, C), dtype=bool))

    def step(state, xs):
        qc, kc, lfc, ic = xs
        b = jnp.cumsum(lfc, axis=2)
        rel = b[:, :, :, None, :] - b[:, :, None, :, :]
        decay = jnp.where(causal[:, :, None], jnp.exp(jnp.minimum(rel, 0.0)), 0.0)
        attn = jnp.einsum('bhtd,bhtsd,bhsd->bhts', qc, decay, kc)
        o = (jnp.einsum('bhts,bhsv->bhtv', attn, ic)
             + jnp.einsum('bhtd,bhdv->bhtv', qc * jnp.exp(b), state))
        b_last = b[:, :, -1:, :]
        state = (jnp.exp(b_last[:, :, 0, :])[..., None] * state
                 + jnp.einsum('bhsd,bhsv->bhdv', kc * jnp.exp(b_last - b), ic))
        return state, o

    state0 = jnp.zeros((B, H, dk, dv), jnp.float32)
    xs = (to_chunks(qf, dk), to_chunks(kf, dk), to_chunks(log_f, dk), to_chunks(inp, dv))
    _, o = lax.scan(step, state0, xs)
    o = o.transpose(1, 0, 3, 2, 4).reshape(B, S, H, dv)
    o = o * lax.rsqrt(jnp.mean(o * o, axis=-1, keepdims=True) + NORM_EPS) * norm_w.astype(jnp.float32)
    o = o * jax.nn.silu(g.astype(jnp.float32).reshape(B, S, H, dv))
    return o.reshape(B, S, HGRN_VDIM).astype(q.dtype)


def moba_mix(q, k, v):
    B, S, _ = q.shape
    H, Dh, BS, QC = MOBA_HEADS, MOBA_HEAD_DIM, MOBA_BLOCK, MOBA_Q_CHUNK
    S_pad = -(-S // BS) * BS
    NB = S_pad // BS
    kt = min(MOBA_TOPK, NB)
    nqc = S_pad // QC
    scale = Dh ** -0.5
    pad = ((0, 0), (0, S_pad - S), (0, 0))

    def heads(t):
        return jnp.pad(t, pad).reshape(B, S_pad, H, Dh).transpose(0, 2, 1, 3)

    qh, kh, vh = heads(q), heads(k), heads(v)
    k_blocks = kh.reshape(B, H, NB, BS, Dh)
    v_blocks = vh.reshape(B, H, NB, BS, Dh)

    k_mean = jnp.mean(k_blocks.astype(jnp.float32), axis=3)
    gate = jnp.einsum('bhsd,bhnd->bhsn', qh.astype(jnp.float32), k_mean)
    q_block = jnp.arange(S_pad) // BS
    past = jnp.arange(NB)[None, :] < q_block[:, None]
    gate = jnp.where(past, gate, MASK_VALUE)
    _, sel = lax.top_k(gate, kt)
    sel_valid = jnp.arange(kt)[None, :] < jnp.minimum(q_block, kt)[:, None]

    q_ch = qh.reshape(B, H, nqc, QC, Dh).transpose(2, 0, 1, 3, 4)
    sel_ch = sel.reshape(B, H, nqc, QC, kt).transpose(2, 0, 1, 3, 4)
    valid_ch = sel_valid.reshape(nqc, QC, kt)
    gather_blocks = jax.vmap(jax.vmap(lambda blk, ix: blk[ix]))
    slopes = alibi_slopes(H)

    def attend(args):
        c, qc, ic, vc = args
        t_pos = c * QC + jnp.arange(QC)
        own_start = (c * QC // BS) * BS
        k_own = lax.dynamic_slice_in_dim(kh, own_start, BS, axis=2)
        v_own = lax.dynamic_slice_in_dim(vh, own_start, BS, axis=2)
        k_sel = gather_blocks(k_blocks, ic)
        v_sel = gather_blocks(v_blocks, ic)
        dist_sel = (t_pos[None, None, :, None, None]
                    - (ic[..., None] * BS + jnp.arange(BS))).astype(jnp.float32)
        s_sel = (jnp.einsum('bhtd,bhtrkd->bhtrk', qc, k_sel, preferred_element_type=jnp.float32) * scale
                 - slopes[None, :, None, None, None] * jnp.abs(dist_sel))
        s_sel = jnp.where(vc[:, :, None], s_sel, MASK_VALUE)
        dist_own = t_pos[:, None] - (own_start + jnp.arange(BS))[None, :]
        s_own = (jnp.einsum('bhtd,bhkd->bhtk', qc, k_own, preferred_element_type=jnp.float32) * scale
                 - slopes[None, :, None, None] * jnp.abs(dist_own).astype(jnp.float32))
        s_own = jnp.where(dist_own >= 0, s_own, MASK_VALUE)
        scores = jnp.concatenate([s_sel.reshape(B, H, QC, kt * BS), s_own], axis=-1)
        p = jax.nn.softmax(scores, axis=-1)
        p_sel = p[..., :kt * BS].reshape(B, H, QC, kt, BS)
        p_own = p[..., kt * BS:]
        out = (jnp.einsum('bhtrk,bhtrkd->bhtd', p_sel, v_sel.astype(jnp.float32))
               + jnp.einsum('bhtk,bhkd->bhtd', p_own, v_own.astype(jnp.float32)))
        return out.astype(q.dtype)

    out = lax.map(attend, (jnp.arange(nqc, dtype=jnp.int32), q_ch, sel_ch, valid_ch))
    out = out.transpose(1, 2, 0, 3, 4).reshape(B, H, S_pad, Dh)[:, :, :S]
    return out.transpose(0, 2, 1, 3).reshape(B, S, MOBA_DIM)


def setup_inputs(seed: int = 0) -> dict:
    key = jax.random.key(seed)
    ks = jax.random.split(key, 16)
    f32 = jnp.float32

    def w(k, shape, fan_in):
        return jax.random.normal(k, shape, f32) * (fan_in ** -0.5)

    def gain(k, shape):
        return 1.0 + 0.01 * jax.random.normal(k, shape, f32)

    return {
        'x': jax.random.normal(ks[0], (BATCH, SEQ, D_MODEL), f32),
        'ffn1_norm': gain(ks[1], (DEPTH, D_MODEL)),
        'ffn1_w_gu': w(ks[2], (DEPTH, D_MODEL, 2 * D_FF), D_MODEL),
        'ffn1_w_down': w(ks[3], (DEPTH, D_FF, D_MODEL), D_FF),
        'mix_norm': gain(ks[4], (DEPTH, D_MODEL)),
        'w_in': w(ks[5], (DEPTH, D_MODEL, D_IN), D_MODEL),
        'hgrn_lb_logits': 0.5 * jax.random.normal(ks[6], (DEPTH, HGRN_KDIM), f32),
        'hgrn_norm': gain(ks[7], (DEPTH, HGRN_HEAD_V)),
        'w_branch_a': w(ks[8], (DEPTH, HGRN_VDIM, D_MODEL), HGRN_VDIM),
        'w_branch_b': w(ks[9], (DEPTH, MOBA_DIM, D_MODEL), MOBA_DIM),
        'w_out': w(ks[10], (DEPTH, D_MODEL, D_MODEL), D_MODEL),
        'ffn2_norm': gain(ks[11], (DEPTH, D_MODEL)),
        'ffn2_w_gu': w(ks[12], (DEPTH, D_MODEL, 2 * D_FF), D_MODEL),
        'ffn2_w_down': w(ks[13], (DEPTH, D_FF, D_MODEL), D_FF),
        'final_norm': gain(ks[14], (D_MODEL,)),
    }


def reference(x, ffn1_norm, ffn1_w_gu, ffn1_w_down, mix_norm, w_in, hgrn_lb_logits, hgrn_norm,
              w_branch_a, w_branch_b, w_out, ffn2_norm, ffn2_w_gu, ffn2_w_down, final_norm):
    lb_sm = jax.nn.softmax(hgrn_lb_logits.astype(jnp.float32), axis=0)
    lower_bounds = jnp.cumsum(lb_sm, axis=0) - lb_sm[0]
    for l in range(DEPTH):
        x = x + 0.5 * swiglu(rmsnorm(x, ffn1_norm[l]), ffn1_w_gu[l], ffn1_w_down[l])
        h = rmsnorm(x, mix_norm[l])
        hq, hf, hi, hg, mq, mk, mv, gates = jnp.split(h @ w_in[l], IN_SPLITS, axis=-1)
        o_a = hgrn2_mix(hq, hf, hi, hg, lower_bounds[l], hgrn_norm[l])
        o_b = moba_mix(mq, mk, mv)
        gate_a, gate_b = jnp.split(jax.nn.sigmoid(gates), 2, axis=-1)
        merged = gate_a * (o_a @ w_branch_a[l]) + gate_b * (o_b @ w_branch_b[l])
        x = x + merged @ w_out[l]
        x = x + 0.5 * swiglu(rmsnorm(x, ffn2_norm[l]), ffn2_w_gu[l], ffn2_w_down[l])
    return rmsnorm(x, final_norm)
```

```cpp
#include <hip/hip_runtime.h>
#include <cstdio>
#include <cstdint>
namespace pg8 {
#define PG8_LAS __attribute__((address_space(3)))
typedef unsigned short bf16_t;
typedef short bf16x8 __attribute__((ext_vector_type(8)));
typedef float f32x4 __attribute__((ext_vector_type(4)));
typedef unsigned u32x4 __attribute__((ext_vector_type(4)));
constexpr int BM = 256, BK = 64, HALF = 128, HTB = HALF * BK * 2  , STAGE_BYTES = 8 * HTB, NXCD = 8, WGM = 8;

__host__ __device__ __forceinline__ int lds_byte(int r, int c) { const int st = (r >> 4) * 2 + (c >> 5), rr = r & 15, cc = c & 31, ob = rr * 64 + cc * 2; return st * 1024 + (ob ^ (((ob >> 9) & 1) << 5)); }
__host__ __device__ __forceinline__ void stage_rc(int b, int& R, int& C) { const int st = b / 1024, sb = b % 1024, swz = sb ^ (((sb >> 9) & 1) << 5); R = (st >> 1) * 16 + swz / 64; C = (st & 1) * 32 + (swz % 64) / 2; }
__host__ __device__ __forceinline__ int perm32(int rho) { const int n = rho >> 4, i = rho & 15; return 8 * (i >> 2) + 4 * n + (i & 3); }

struct Unit { int pm, pn; };
struct Gemm { const bf16_t* A; const bf16_t* Bt; int M, N, K, lda; };

struct StaticOrder {
    int nM, nN, nwg, G, c;
    __host__ __device__ void init(int M, int N, int G_, int c_) { nM = M / BM; nN = N / BM; nwg = nM * nN; G = G_; c = c_; }
    __host__ __device__ bool next(int i, Unit& u) const {
        const long L = (long)i * G + c; if (L >= nwg) return false;
        int wgid = (int)L; { const int q = nwg / NXCD, r = nwg % NXCD, xcd = wgid % NXCD, off = wgid / NXCD; wgid = (xcd < r ? xcd * (q + 1) : r * (q + 1) + (xcd - r) * q) + off; }
        const int nig = WGM * nN, gid = wgid / nig, fm = gid * WGM, gsz = (nM - fm) < WGM ? (nM - fm) : WGM;
        u.pm = fm + ((wgid % nig) % gsz); u.pn = (wgid % nig) / gsz; return true;
    }
    __device__ __forceinline__ void a_ready(const Unit&) const {}
    __device__ __forceinline__ void done(const Unit&) const {}
};

__device__ __forceinline__ unsigned cvt_pk_bf16(float lo, float hi) { unsigned r; asm volatile("v_cvt_pk_bf16_f32 %0, %1, %2" : "=v"(r) : "v"(lo), "v"(hi)); return r; }
typedef float f32x2 __attribute__((ext_vector_type(2)));
__device__ __forceinline__ float bf_lo(unsigned u) { return __uint_as_float(u << 16); }
__device__ __forceinline__ float bf_hi(unsigned u) { return __uint_as_float(u & 0xffff0000u); }
__device__ __forceinline__ float sigm(float x) { return __builtin_amdgcn_rcpf(1.0f + __builtin_amdgcn_exp2f(x * -1.4426950408889634f)); }

struct EpiStoreBf16 {
    static constexpr bool PERM = true, AFTER_DRAIN = false;
    bf16_t* O; int ldc;
    __device__ __forceinline__ void operator()(const f32x4 (&acc)[2][2][4][2], const Unit& u, int wr, int wc, int fr, int fq) const {
        const int row0 = u.pm * BM + wr * 64 + fr, col0 = u.pn * BM + wc * 32 + 8 * fq;
#pragma unroll
        for (int ai = 0; ai < 2; ++ai)
#pragma unroll
            for (int m = 0; m < 4; ++m) { bf16_t* rowp = O + (size_t)(row0 + ai * HALF + m * 16) * ldc + col0;
#pragma unroll
                for (int bj = 0; bj < 2; ++bj) { const f32x4 v0 = acc[ai][bj][m][0], v1 = acc[ai][bj][m][1];
                    u32x4 w; w.x = cvt_pk_bf16(v0[0], v0[1]); w.y = cvt_pk_bf16(v0[2], v0[3]); w.z = cvt_pk_bf16(v1[0], v1[1]); w.w = cvt_pk_bf16(v1[2], v1[3]);
                    *(u32x4*)(rowp + bj * HALF) = w; } }
    }
};
struct EpiSwiGLU {
    static constexpr bool PERM = true, AFTER_DRAIN = false;
    bf16_t* O; int ldc;
    __device__ __forceinline__ void operator()(const f32x4 (&acc)[2][2][4][2], const Unit& u, int wr, int wc, int fr, int fq) const {
        const int row0 = u.pm * BM + wr * 64 + fr, col0 = u.pn * HALF + wc * 32 + 8 * fq;
#pragma unroll
        for (int ai = 0; ai < 2; ++ai)
#pragma unroll
            for (int m = 0; m < 4; ++m) { bf16_t* rowp = O + (size_t)(row0 + ai * HALF + m * 16) * ldc + col0;
                float a[8];
#pragma unroll
                for (int n = 0; n < 2; ++n)
#pragma unroll
                    for (int e = 0; e < 4; ++e) { const float g = acc[ai][0][m][n][e], up = acc[ai][1][m][n][e]; a[n * 4 + e] = g * sigm(g) * up; }
                u32x4 w; w.x = cvt_pk_bf16(a[0], a[1]); w.y = cvt_pk_bf16(a[2], a[3]); w.z = cvt_pk_bf16(a[4], a[5]); w.w = cvt_pk_bf16(a[6], a[7]);
                *(u32x4*)rowp = w; }
    }
};
struct EpiResid {
    static constexpr bool PERM = false, AFTER_DRAIN = false;
    const float* base; float* out; int ldc; float scale;
    __device__ __forceinline__ void operator()(const f32x4 (&acc)[2][2][4][2], const Unit& u, int wr, int wc, int fr, int fq) const {
        const int row0 = u.pm * BM + wr * 64 + fr, col0 = u.pn * BM + wc * 32 + 4 * fq;
#pragma unroll
        for (int ai = 0; ai < 2; ++ai)
#pragma unroll
            for (int m = 0; m < 4; ++m) { const size_t off = (size_t)(row0 + ai * HALF + m * 16) * ldc + col0;
#pragma unroll
                for (int bj = 0; bj < 2; ++bj)
#pragma unroll
                    for (int n = 0; n < 2; ++n) { const f32x4 bs = *(const f32x4*)(base + off + bj * HALF + n * 16); *(f32x4*)(out + off + bj * HALF + n * 16) = bs + acc[ai][bj][m][n] * scale; }
                if (m & 1) asm volatile("" ::: "memory"); }
    }
};
template <int MODE> struct EpiGate {
    static constexpr bool PERM = true, AFTER_DRAIN = false;
    const bf16_t* G; int ldg; const bf16_t* P; int ldp; bf16_t* O; int ldo;
    __device__ __forceinline__ void operator()(const f32x4 (&acc)[2][2][4][2], const Unit& u, int wr, int wc, int fr, int fq) const {
        const int row0 = u.pm * BM + wr * 64 + fr, col0 = u.pn * BM + wc * 32 + 8 * fq;
#pragma unroll
        for (int ai = 0; ai < 2; ++ai)
#pragma unroll
            for (int m = 0; m < 4; ++m) { const size_t row = (size_t)(row0 + ai * HALF + m * 16);
#pragma unroll
                for (int bj = 0; bj < 2; ++bj) { const int c = col0 + bj * HALF;
                    const u32x4 gv = *(const u32x4*)(G + row * ldg + c);
                    const f32x4 v0 = acc[ai][bj][m][0], v1 = acc[ai][bj][m][1];
                    float a[8];
                    a[0] = sigm(bf_lo(gv.x)) * v0[0]; a[1] = sigm(bf_hi(gv.x)) * v0[1]; a[2] = sigm(bf_lo(gv.y)) * v0[2]; a[3] = sigm(bf_hi(gv.y)) * v0[3];
                    a[4] = sigm(bf_lo(gv.z)) * v1[0]; a[5] = sigm(bf_hi(gv.z)) * v1[1]; a[6] = sigm(bf_lo(gv.w)) * v1[2]; a[7] = sigm(bf_hi(gv.w)) * v1[3];
                    if (MODE == 1) { const u32x4 pv = *(const u32x4*)(P + row * ldp + c);
                        a[0] += bf_lo(pv.x); a[1] += bf_hi(pv.x); a[2] += bf_lo(pv.y); a[3] += bf_hi(pv.y); a[4] += bf_lo(pv.z); a[5] += bf_hi(pv.z); a[6] += bf_lo(pv.w); a[7] += bf_hi(pv.w); }
                    u32x4 w; w.x = cvt_pk_bf16(a[0], a[1]); w.y = cvt_pk_bf16(a[2], a[3]); w.z = cvt_pk_bf16(a[4], a[5]); w.w = cvt_pk_bf16(a[6], a[7]);
                    *(u32x4*)(O + row * ldo + c) = w; }
                asm volatile("" ::: "memory"); }
    }
};

template <int MC, int NC> struct StaticOrderC {
    static constexpr int nM = MC / BM, nN = NC / BM, nwg = nM * nN;
    int G, c;
    __device__ __forceinline__ void init(int G_, int c_) { asm volatile("" : "+s"(G_), "+s"(c_)); G = G_; c = c_; }
    __device__ __forceinline__ bool next(int i, Unit& u) const {
        const int L = i * G + c; if (L >= nwg) return false;
        int wgid = L; { constexpr int q = nwg / NXCD, r = nwg % NXCD; const int xcd = wgid % NXCD, off = wgid / NXCD; wgid = (xcd < r ? xcd * (q + 1) : r * (q + 1) + (xcd - r) * q) + off; }
        constexpr int nig = WGM * nN; const int gid = wgid / nig, fm = gid * WGM, gsz = (nM - fm) < WGM ? (nM - fm) : WGM;
        u.pm = fm + ((wgid % nig) % gsz); u.pn = (wgid % nig) / gsz; return true;
    }
    __device__ __forceinline__ void a_ready(const Unit&) const {}
    __device__ __forceinline__ void done(const Unit&) const {}
};

template <class Epi, class Sched, bool ALIGN_EPI, bool SP2, int KC, int LDAC>
__device__ __forceinline__ void gemm_phase(PG8_LAS unsigned char* lds, const Gemm g, const Sched& S, const Epi& E) {
    int tid_ = threadIdx.x; asm volatile("" : "+v"(tid_));
    const int tid = tid_, wid = __builtin_amdgcn_readfirstlane(tid >> 6), lane = tid & 63, wr = wid >> 2, wc = wid & 3, fr = lane & 15, fq = lane >> 4;
    constexpr int K = KC, nt = K / BK; static_assert(KC % 128 == 0 && KC >= 256, "K multiple of 128, >= 256");
    unsigned voffA[2], voffB[2];
#pragma unroll
    for (int i = 0; i < 2; ++i) { int R, C; stage_rc(tid * 16 + i * 8192, R, C); const int Rb = Epi::PERM ? ((R & ~31) + perm32(R & 31)) : R;
        voffA[i] = (unsigned)(R * LDAC + C) * 2u; voffB[i] = (unsigned)(Rb * K + C) * 2u; }
    constexpr size_t kstep = (size_t)(BK * 2);
    constexpr size_t hstepA = (size_t)HALF * LDAC * 2, hstepB = (size_t)HALF * K * 2;
    constexpr size_t tstepA = 2 * hstepA, tstepB = 2 * hstepB;
    const unsigned ldsw = (unsigned)wid * 1024u;
    const int aoff = lds_byte(wr * 64 + fr, fq * 8), boff = lds_byte(wc * 32 + fr, fq * 8);
#define PG8_SA(b, h) (((b) * 2 + (h)) * HTB)
#define PG8_SB(b, h) ((4 + (b) * 2 + (h)) * HTB)
#define PG8_STAGE(bufoff, gbase, voff) do { _Pragma("unroll") for (int _i = 0; _i < 2; ++_i) \
        __builtin_amdgcn_global_load_lds((const unsigned*)((const char*)(gbase) + (voff)[_i]), (PG8_LAS unsigned*)(lds + (bufoff) + ldsw + _i * 8192), 16, 0, 0); } while (0)
#define PG8_LDA(dst, b, h) do { _Pragma("unroll") for (int m = 0; m < 4; ++m) _Pragma("unroll") for (int k = 0; k < 2; ++k) dst[m][k] = *(const PG8_LAS bf16x8*)(lds + PG8_SA(b, h) + aoff + m * 2048 + k * 1024); } while (0)
#define PG8_LDB(dst, b, h) do { _Pragma("unroll") for (int n = 0; n < 2; ++n) _Pragma("unroll") for (int k = 0; k < 2; ++k) dst[n][k] = *(const PG8_LAS bf16x8*)(lds + PG8_SB(b, h) + boff + n * 2048 + k * 1024); } while (0)
#define PG8_MMA(ai, bj, At, Bt) do { __builtin_amdgcn_s_setprio(1); _Pragma("unroll") for (int m = 0; m < 4; ++m) _Pragma("unroll") for (int n = 0; n < 2; ++n) _Pragma("unroll") for (int k = 0; k < 2; ++k) \
        acc[ai][bj][m][n] = __builtin_amdgcn_mfma_f32_16x16x32_bf16(Bt[n][k], At[m][k], acc[ai][bj][m][n], 0, 0, 0); __builtin_amdgcn_s_setprio(0); } while (0)
#define PG8_WAIT_V(n) asm volatile("s_waitcnt vmcnt(" #n ")" ::: "memory")
#define PG8_WAIT_L(n) asm volatile("s_waitcnt lgkmcnt(" #n ")" ::: "memory")
#define PG8_BAR __builtin_amdgcn_s_barrier()
#define PG8_SCHED __builtin_amdgcn_sched_barrier(0)
    Unit cur, nxt; int ui = 0;
    if (!S.next(0, cur)) return;
    f32x4 acc[2][2][4][2];
#pragma unroll
    for (int a = 0; a < 2; ++a)
#pragma unroll
        for (int b = 0; b < 2; ++b)
#pragma unroll
            for (int m = 0; m < 4; ++m)
#pragma unroll
                for (int n = 0; n < 2; ++n) acc[a][b][m][n] = (f32x4){0.f, 0.f, 0.f, 0.f};
    bf16x8 At[4][2], B0[2][2], B1[2][2];
    const char* cA = (const char*)g.A + (size_t)cur.pm * tstepA; const char* cB = (const char*)g.Bt + (size_t)cur.pn * tstepB;
    S.a_ready(cur);
    if constexpr (SP2) {
        PG8_STAGE(PG8_SB(0, 0), cB, voffB); PG8_STAGE(PG8_SB(0, 1), cB + hstepB, voffB); PG8_STAGE(PG8_SA(0, 0), cA, voffA); PG8_STAGE(PG8_SA(0, 1), cA + hstepA, voffA);
        if (wr == 1) PG8_BAR;
        PG8_WAIT_V(2); PG8_BAR;
        PG8_STAGE(PG8_SB(1, 0), cB + kstep, voffB); PG8_STAGE(PG8_SA(1, 0), cA + kstep, voffA); PG8_STAGE(PG8_SB(1, 1), cB + hstepB + kstep, voffB);
        PG8_WAIT_V(6); PG8_BAR;
    } else {
        PG8_STAGE(PG8_SB(0, 0), cB, voffB); PG8_STAGE(PG8_SA(0, 0), cA, voffA); PG8_STAGE(PG8_SB(0, 1), cB + hstepB, voffB); PG8_STAGE(PG8_SA(0, 1), cA + hstepA, voffA);
        if (wr == 1) PG8_BAR;
        PG8_WAIT_V(4); PG8_BAR;
        PG8_STAGE(PG8_SB(1, 0), cB + kstep, voffB); PG8_STAGE(PG8_SA(1, 0), cA + kstep, voffA); PG8_STAGE(PG8_SB(1, 1), cB + hstepB + kstep, voffB);
        PG8_WAIT_V(6); PG8_BAR;
    }
    for (;;) {
        const bool has_next = S.next(ui + 1, nxt);
        const char* nA = has_next ? (const char*)g.A + (size_t)nxt.pm * tstepA : cA; const char* nB = has_next ? (const char*)g.Bt + (size_t)nxt.pn * tstepB : cB;
        for (int t = 0; t < nt; t += 2) {
            const bool last = (t == nt - 2);
            const char* a1 = cA + (size_t)(t + 1) * kstep;
            const char* a2 = last ? nA : cA + (size_t)(t + 2) * kstep; const char* b2 = last ? nB : cB + (size_t)(t + 2) * kstep;
            const char* a3 = a2 + kstep; const char* b3 = b2 + kstep;
            if (last && has_next) S.a_ready(nxt);
            if constexpr (SP2) {
            PG8_LDB(B0, 0, 0); PG8_LDB(B1, 0, 1); PG8_SCHED; PG8_LDA(At, 0, 0); PG8_STAGE(PG8_SA(1, 1), a1 + hstepA, voffA);
            PG8_WAIT_V(8); PG8_WAIT_L(0); PG8_BAR; PG8_MMA(0, 0, At, B0); PG8_MMA(0, 1, At, B1); PG8_BAR; PG8_SCHED;
            PG8_LDA(At, 0, 1); PG8_STAGE(PG8_SB(0, 0), b2, voffB); PG8_STAGE(PG8_SB(0, 1), b2 + hstepB, voffB); PG8_STAGE(PG8_SA(0, 0), a2, voffA);
            PG8_WAIT_V(8); PG8_WAIT_L(0); PG8_BAR; PG8_MMA(1, 0, At, B0); PG8_MMA(1, 1, At, B1); PG8_BAR; PG8_SCHED;
            PG8_LDB(B0, 1, 0); PG8_LDB(B1, 1, 1); PG8_SCHED; PG8_LDA(At, 1, 0); PG8_STAGE(PG8_SA(0, 1), a2 + hstepA, voffA);
            PG8_WAIT_V(8); PG8_WAIT_L(0); PG8_BAR; PG8_MMA(0, 0, At, B0); PG8_MMA(0, 1, At, B1); PG8_BAR; PG8_SCHED;
            PG8_LDA(At, 1, 1); PG8_STAGE(PG8_SB(1, 0), b3, voffB); PG8_STAGE(PG8_SB(1, 1), b3 + hstepB, voffB); PG8_STAGE(PG8_SA(1, 0), a3, voffA);
            PG8_WAIT_V(8); PG8_WAIT_L(0); PG8_BAR; PG8_MMA(1, 0, At, B0); PG8_MMA(1, 1, At, B1); PG8_BAR; PG8_SCHED;
            } else {
            PG8_LDB(B0, 0, 0); PG8_SCHED; PG8_LDA(At, 0, 0); PG8_STAGE(PG8_SA(1, 1), a1 + hstepA, voffA);
            PG8_WAIT_L(8); PG8_BAR; PG8_WAIT_L(0); PG8_MMA(0, 0, At, B0); PG8_BAR; PG8_SCHED;
            PG8_LDB(B1, 0, 1); PG8_STAGE(PG8_SB(0, 0), b2, voffB);
            PG8_BAR; PG8_WAIT_L(0); PG8_MMA(0, 1, At, B1); PG8_BAR;
            PG8_LDA(At, 0, 1); PG8_STAGE(PG8_SA(0, 0), a2, voffA);
            PG8_BAR; PG8_WAIT_L(0); PG8_MMA(1, 0, At, B0); PG8_BAR; PG8_SCHED;
            PG8_STAGE(PG8_SB(0, 1), b2 + hstepB, voffB);
            PG8_WAIT_V(6); PG8_BAR; PG8_MMA(1, 1, At, B1); PG8_BAR;
            PG8_LDB(B0, 1, 0); PG8_SCHED; PG8_LDA(At, 1, 0); PG8_STAGE(PG8_SA(0, 1), a2 + hstepA, voffA);
            PG8_WAIT_L(8); PG8_BAR; PG8_WAIT_L(0); PG8_MMA(0, 0, At, B0); PG8_BAR; PG8_SCHED;
            PG8_LDB(B1, 1, 1); PG8_STAGE(PG8_SB(1, 0), b3, voffB);
            PG8_BAR; PG8_WAIT_L(0); PG8_MMA(0, 1, At, B1); PG8_BAR;
            PG8_LDA(At, 1, 1); PG8_STAGE(PG8_SA(1, 0), a3, voffA);
            PG8_BAR; PG8_WAIT_L(0); PG8_MMA(1, 0, At, B0); PG8_BAR; PG8_SCHED;
            PG8_STAGE(PG8_SB(1, 1), b3 + hstepB, voffB);
            PG8_WAIT_V(6); PG8_BAR; PG8_MMA(1, 1, At, B1); PG8_BAR;
            }
        }
        if constexpr (ALIGN_EPI) { if (wr == 0) PG8_BAR; }
        if constexpr (!Epi::AFTER_DRAIN) { E(acc, cur, wr, wc, fr, fq); S.done(cur); }
        if (!has_next) break;
#pragma unroll
        for (int a = 0; a < 2; ++a)
#pragma unroll
            for (int b = 0; b < 2; ++b)
#pragma unroll
                for (int m = 0; m < 4; ++m)
#pragma unroll
                    for (int n = 0; n < 2; ++n) acc[a][b][m][n] = (f32x4){0.f, 0.f, 0.f, 0.f};
        cur = nxt; cA = nA; cB = nB; ++ui;
        if constexpr (ALIGN_EPI) { if (wr == 1) PG8_BAR; }
    }
    PG8_WAIT_V(0);
    if constexpr (!ALIGN_EPI) { if (wr == 0) PG8_BAR; }
    PG8_BAR;
    if constexpr (Epi::AFTER_DRAIN) { E.fused(acc, cur, wr, wc, fr, fq, lds, wid, lane); S.done(cur); }
#undef PG8_SA
#undef PG8_SB
#undef PG8_STAGE
#undef PG8_LDA
#undef PG8_LDB
#undef PG8_MMA
#undef PG8_WAIT_V
#undef PG8_WAIT_L
#undef PG8_BAR
#undef PG8_SCHED
}
}
#define GAS __attribute__((address_space(1)))
#define LAS __attribute__((address_space(3)))
typedef unsigned short bf16;
typedef unsigned v4u __attribute__((ext_vector_type(4)));
typedef float f32x4 __attribute__((ext_vector_type(4)));
typedef short bf16x8 __attribute__((ext_vector_type(8)));
typedef GAS unsigned gu32;
typedef GAS unsigned long long gu64;
#define RLX_AGENT __ATOMIC_RELAXED, __HIP_MEMORY_SCOPE_AGENT
#define LDS_WAIT() asm volatile("s_waitcnt lgkmcnt(0)" ::: "memory")
#define VM_WAIT() asm volatile("s_waitcnt vmcnt(0)" ::: "memory")
__device__ __forceinline__ unsigned long long rt() { return __builtin_amdgcn_s_memrealtime(); }
__device__ __forceinline__ unsigned f2bf(float f) { unsigned u = __builtin_bit_cast(unsigned, f); return (u + 0x7fffu + ((u >> 16) & 1u)) >> 16; }
__device__ __forceinline__ unsigned pk2(float lo, float hi) { return f2bf(lo) | (f2bf(hi) << 16); }
#define XB_TMO      128
#define XB_XCNT(j)  (256  + 64 * (j))
#define XB_XSUB(j)  (1280 + 64 * (j))
#define XB_XGEN(j)  (2304 + 64 * (j))
#define XB_TOP      3328
#define XB_TOPGEN   3392
#define XCD_BAR_WORDS 3456
#define XB_SPIN_CAP (1u << 18)

__device__ __forceinline__ unsigned xb_ld(unsigned* p)              { return __hip_atomic_load(p, __ATOMIC_RELAXED, __HIP_MEMORY_SCOPE_AGENT); }
__device__ __forceinline__ unsigned xb_add(unsigned* p, unsigned v) { return __hip_atomic_fetch_add(p, v, __ATOMIC_RELAXED, __HIP_MEMORY_SCOPE_AGENT); }
__device__ __forceinline__ unsigned xb_xcc_id() { return (unsigned)__builtin_amdgcn_s_getreg((3 << 11) | 20) & 0xFu; }
#define XB_SPIN(cond, bar) do { unsigned _sp = 0; while (cond) { __builtin_amdgcn_s_sleep(1); \
    if ((++_sp & 255u) == 0u) { if (xb_ld(&(bar)[XB_TMO])) break; if (_sp > XB_SPIN_CAP) { atomicAdd(&(bar)[XB_TMO], 1u); break; } } } } while (0)

struct XcdBarrier {
    unsigned* bar; unsigned x;
    volatile LAS unsigned* st;
};

__device__ __forceinline__ XcdBarrier xcd_barrier_post(unsigned* bar, volatile LAS unsigned* st) {
    XcdBarrier b; b.bar = bar; b.x = xb_xcc_id(); b.st = st;
    if (threadIdx.x == 0) (void)xb_add(&bar[XB_XCNT(b.x)], 1u);
    return b;
}
__device__ __forceinline__ void xcd_barrier_complete(unsigned* bar, unsigned x, unsigned& nloc, unsigned& nx) {
    const unsigned G = gridDim.x * gridDim.y * gridDim.z;
    unsigned sum, cnt, mine, sp = 0u;
    for (;;) {
        sum = 0u; cnt = 0u; mine = 0u;
#pragma unroll
        for (unsigned j = 0; j < 16; ++j) { const unsigned c = xb_ld(&bar[XB_XCNT(j)]); sum += c; cnt += (c > 0u) ? 1u : 0u; mine = (j == x) ? c : mine; }
        if (sum == G) break;
        __builtin_amdgcn_s_sleep(1);
        if ((++sp & 255u) == 0u) { if (xb_ld(&bar[XB_TMO])) break; if (sp > XB_SPIN_CAP) { atomicAdd(&bar[XB_TMO], 1u); break; } }
    }
    nloc = mine > 0u ? mine : 1u; nx = cnt > 0u ? cnt : 1u;
}

__device__ __forceinline__ void xcd_barrier(const XcdBarrier& b) {
    asm volatile("s_waitcnt vmcnt(0)" ::: "memory");
    __syncthreads();
    if (threadIdx.x == 0) {
        unsigned* bar = b.bar;
        __builtin_amdgcn_s_waitcnt(0);
        unsigned nloc = b.st[0], nx = b.st[1];
        if (nloc == 0u) { xcd_barrier_complete(bar, b.x, nloc, nx); b.st[0] = nloc; b.st[1] = nx; }
        const unsigned old = xb_add(&bar[XB_XSUB(b.x)], 1u);
        const unsigned gen = old / nloc;
        if (old + 1u == (gen + 1u) * nloc) {
            __builtin_amdgcn_fence(__ATOMIC_RELEASE, "agent");
            asm volatile("s_waitcnt vmcnt(0)" ::: "memory");
            const unsigned og = xb_add(&bar[XB_TOP], 1u);
            const unsigned tg = og / nx;
            if (og + 1u == (tg + 1u) * nx) xb_add(&bar[XB_TOPGEN], 1u);
            else XB_SPIN(xb_ld(&bar[XB_TOPGEN]) == tg, bar);
            __builtin_amdgcn_fence(__ATOMIC_ACQUIRE, "agent");
            xb_add(&bar[XB_XGEN(b.x)], 1u);
            asm volatile("s_waitcnt vmcnt(0)" ::: "memory");
        } else {
            XB_SPIN(xb_ld(&bar[XB_XGEN(b.x)]) == gen, bar);
            __builtin_amdgcn_fence(__ATOMIC_ACQUIRE, "agent");
            asm volatile("s_waitcnt vmcnt(0)" ::: "memory");
        }
    }
    __syncthreads();
}

constexpr int NWAVES = 8;
constexpr int BATCH = 8, SEQ = 4096, DM = 1024, MROWS = BATCH * SEQ, DEPTH = 2;
constexpr int DFF = 2816, DIN = 5632;
constexpr int HG_H = 4, HG_D = 128, HG_W = 512;
constexpr int MB_H = 8, MB_D = 64, MB_BS = 256, MB_NB = SEQ / MB_BS;
constexpr int C_HQ = 0, C_HF = 512, C_HI = 1024, C_HG = 1536, C_MQ = 2048, C_MK = 2560, C_MV = 3072, C_GA = 3584, C_GB = 4608;
constexpr float NORM_EPS = 1e-6f, MIN_FORGET = 1e-20f, LOG2E = 1.4426950408889634f;

constexpr size_t MiB = 1u << 20;
constexpr size_t WS_CTL = 0, CTL_ZERO_BYTES = 1 * MiB;
constexpr size_t WS_LB = 1 * MiB;
constexpr size_t WS_KMEAN = 1 * MiB + 65536;
constexpr size_t WS_W = 8 * MiB;
constexpr size_t W_GU1 = 0, W_DN1 = 11 * MiB, W_IN = W_DN1 + 11 * MiB / 2, W_A = W_IN + 11 * MiB, W_B = W_A + 1 * MiB, W_OUT = W_B + 1 * MiB, W_GU2 = W_OUT + 2 * MiB, W_DN2 = W_GU2 + 11 * MiB, W_END = W_DN2 + 11 * MiB / 2;
static_assert(W_END == 48 * MiB, "weight map");
constexpr size_t WS_H = 56 * MiB;
constexpr size_t WS_BIG = 120 * MiB;
constexpr size_t WS_END = WS_BIG + (size_t)MROWS * DIN * 2;
static_assert(WS_END == 472 * MiB, "d_ws map");
constexpr int CW_TMO = 0, CW_BAR = 4096;

constexpr int RING_OFF = 0, RING_BYTES = 131072;
constexpr int LDSCTL_OFF = RING_BYTES, MISC_OFF = LDSCTL_OFF + 320;
constexpr int LDS_BYTES = 147456;
static_assert(MISC_OFF + 128 <= LDS_BYTES, "LDS map");

struct Frame {
    LAS unsigned char* lds;
    volatile LAS unsigned* MISC;
    gu32* ctl;
    int tid, lane, wave, G;
    unsigned char* ws;
    float* xo;
};

#define PHASE_IDS(F) int tid_ = threadIdx.x; asm volatile("" : "+v"(tid_)); const int tid = tid_, lane = tid & 63, wave = __builtin_amdgcn_readfirstlane(tid >> 6); \
    int bid_ = blockIdx.x, G_ = gridDim.x; asm volatile("" : "+s"(bid_), "+s"(G_)); const int bid = bid_, G = G_; \
    unsigned char* ws = (F).ws; asm volatile("" : "+s"(ws)); LAS unsigned char* ldsb = (F).lds; (void)tid; (void)lane; (void)wave; (void)bid; (void)G; (void)ws; (void)ldsb;
__device__ __forceinline__ float wave_sum(float v) {
#pragma unroll
    for (int o = 1; o < 64; o <<= 1) v += __shfl_xor(v, o);
    return v;
}
__device__ __forceinline__ float wave_max(float v) {
#pragma unroll
    for (int o = 1; o < 64; o <<= 1) v = fmaxf(v, __shfl_xor(v, o));
    return v;
}
__device__ __forceinline__ float bflo(unsigned u) { return __uint_as_float(u << 16); }
__device__ __forceinline__ float bfhi(unsigned u) { return __uint_as_float(u & 0xffff0000u); }
__device__ __forceinline__ float bf1(bf16 u) { return __uint_as_float((unsigned)u << 16); }
__device__ __forceinline__ float sigmoid_f(float x) { return 1.0f / (1.0f + __expf(-x)); }

template <bool GU>
__device__ __forceinline__ void cvt_item(const float* W, int K, int N, bf16* WT, LAS float* scr, int item, int lane) {
    const int nblk = N / 32, kb = item / nblk, nb = item % nblk, k0 = 64 * kb, n0 = 32 * nb;
#pragma unroll 8
    for (int i = 0; i < 32; ++i) { const int kk = 2 * i + (lane >> 5); scr[kk * 33 + (lane & 31)] = W[(size_t)(k0 + kk) * N + n0 + (lane & 31)]; }
    LDS_WAIT(); asm volatile("" ::: "memory");
    int r0 = n0;
    if (GU) { const int j = (n0 >= DFF) ? n0 - DFF : n0; r0 = 256 * (j >> 7) + (j & 127) + ((n0 >= DFF) ? 128 : 0); }
    const int c = lane & 7;
#pragma unroll
    for (int j = 0; j < 4; ++j) { const int n = (lane >> 3) + 8 * j; const LAS float* s = scr + (8 * c) * 33 + n;
        v4u o; o.x = pk2(s[0 * 33], s[1 * 33]); o.y = pk2(s[2 * 33], s[3 * 33]); o.z = pk2(s[4 * 33], s[5 * 33]); o.w = pk2(s[6 * 33], s[7 * 33]);
        *(GAS v4u*)(WT + (size_t)(r0 + n) * K + k0 + 8 * c) = o; }
    LDS_WAIT(); asm volatile("" ::: "memory");
}
__device__ __forceinline__ void phase_convert(Frame& F, const float* const* in, int l) {
    PHASE_IDS(F);
    LAS float* scr = (LAS float*)(ldsb + RING_OFF + wave * 16384);
    const int gw = bid * NWAVES + wave, NGW = G * NWAVES;
    constexpr int I_GU = (DM / 64) * (2 * DFF / 32), I_DN = (DFF / 64) * (DM / 32), I_IN = (DM / 64) * (DIN / 32), I_A = (512 / 64) * (DM / 32), I_O = (DM / 64) * (DM / 32);
    constexpr int NITEMS = 2 * I_GU + 2 * I_DN + I_IN + 2 * I_A + I_O;
    unsigned char* wb = ws + WS_W;
    for (int it = gw; it < NITEMS; it += NGW) {
        int r = it;
        if (r < I_GU) { cvt_item<true>(in[2] + (size_t)l * DM * 2 * DFF, DM, 2 * DFF, (bf16*)(wb + W_GU1), scr, r, lane); continue; } r -= I_GU;
        if (r < I_GU) { cvt_item<true>(in[12] + (size_t)l * DM * 2 * DFF, DM, 2 * DFF, (bf16*)(wb + W_GU2), scr, r, lane); continue; } r -= I_GU;
        if (r < I_IN) { cvt_item<false>(in[5] + (size_t)l * DM * DIN, DM, DIN, (bf16*)(wb + W_IN), scr, r, lane); continue; } r -= I_IN;
        if (r < I_DN) { cvt_item<false>(in[3] + (size_t)l * DFF * DM, DFF, DM, (bf16*)(wb + W_DN1), scr, r, lane); continue; } r -= I_DN;
        if (r < I_DN) { cvt_item<false>(in[13] + (size_t)l * DFF * DM, DFF, DM, (bf16*)(wb + W_DN2), scr, r, lane); continue; } r -= I_DN;
        if (r < I_A) { cvt_item<false>(in[8] + (size_t)l * 512 * DM, 512, DM, (bf16*)(wb + W_A), scr, r, lane); continue; } r -= I_A;
        if (r < I_A) { cvt_item<false>(in[9] + (size_t)l * 512 * DM, 512, DM, (bf16*)(wb + W_B), scr, r, lane); continue; } r -= I_A;
        cvt_item<false>(in[10] + (size_t)l * DM * DM, DM, DM, (bf16*)(wb + W_OUT), scr, r, lane);
    }
}
__device__ __forceinline__ void phase_rmsnorm_bf16(Frame& F, const float* x, const float* gain, bf16* out) {
    PHASE_IDS(F);
    const int gw = bid * NWAVES + wave, NGW = G * NWAVES;
    f32x4 g[4];
#pragma unroll
    for (int j = 0; j < 4; ++j) g[j] = ((const f32x4*)gain)[64 * j + lane];
    for (int m = gw; m < MROWS; m += NGW) {
        const f32x4* xr = (const f32x4*)(x + (size_t)m * DM) + lane;
        f32x4 v[4]; float s = 0.f;
#pragma unroll
        for (int j = 0; j < 4; ++j) { v[j] = xr[64 * j]; s += (v[j].x * v[j].x + v[j].y * v[j].y) + (v[j].z * v[j].z + v[j].w * v[j].w); }
        const float r = 1.0f / sqrtf(wave_sum(s) * (1.0f / DM) + NORM_EPS);
        unsigned long long* o8 = (unsigned long long*)(out + (size_t)m * DM) + lane;
#pragma unroll
        for (int j = 0; j < 4; ++j) o8[64 * j] = (unsigned long long)pk2(v[j].x * r * g[j].x, v[j].y * r * g[j].y) | ((unsigned long long)pk2(v[j].z * r * g[j].z, v[j].w * r * g[j].w) << 32);
    }
}
__device__ __forceinline__ void phase_rmsnorm_f32(Frame& F, float* x, const float* gain) {
    PHASE_IDS(F);
    const int gw = bid * NWAVES + wave, NGW = G * NWAVES;
    f32x4 g[4];
#pragma unroll
    for (int j = 0; j < 4; ++j) g[j] = ((const f32x4*)gain)[64 * j + lane];
    for (int m = gw; m < MROWS; m += NGW) {
        f32x4* xr = (f32x4*)(x + (size_t)m * DM) + lane;
        f32x4 v[4]; float s = 0.f;
#pragma unroll
        for (int j = 0; j < 4; ++j) { v[j] = xr[64 * j]; s += (v[j].x * v[j].x + v[j].y * v[j].y) + (v[j].z * v[j].z + v[j].w * v[j].w); }
        const float r = 1.0f / sqrtf(wave_sum(s) * (1.0f / DM) + NORM_EPS);
#pragma unroll
        for (int j = 0; j < 4; ++j) xr[64 * j] = v[j] * r * g[j];
    }
}
__device__ __forceinline__ void compute_lb(Frame& F, const float* logits) {
    PHASE_IDS(F);
    float* lb = (float*)(ws + WS_LB);
    if (bid == 0) {
        const int d = tid;
        float mx = -INFINITY;
        for (int l = 0; l < DEPTH; ++l) mx = fmaxf(mx, logits[l * 512 + d]);
        float den = 0.f;
        for (int l = 0; l < DEPTH; ++l) den += expf(logits[l * 512 + d] - mx);
        const float sm0 = expf(logits[d] - mx) / den;
        float cum = 0.f;
        for (int l = 0; l < DEPTH; ++l) { cum += expf(logits[l * 512 + d] - mx) / den; lb[l * 512 + d] = fminf(fmaxf(cum - sm0, 0.f), 1.f); }
    }
}
__device__ __forceinline__ void phase_kmean(Frame& F) {
    PHASE_IDS(F);
    const bf16* proj = (const bf16*)(ws + WS_BIG);
    float* kmean = (float*)(ws + WS_KMEAN);
    LAS float* part = (LAS float*)(ldsb + RING_OFF);
    for (int tsk = (int)((bid + G / 2) % G); tsk < BATCH * MB_NB; tsk += G) {
        const int b = tsk >> 4, n = tsk & 15;
        float a[8];
#pragma unroll
        for (int j = 0; j < 8; ++j) a[j] = 0.f;
        const bf16* base = proj + ((size_t)b * SEQ + n * MB_BS + wave * 32) * DIN + C_MK + lane * 8;
#pragma unroll 4
        for (int i = 0; i < 32; ++i) { const v4u kv = *(const v4u*)(base + (size_t)i * DIN);
            a[0] += bflo(kv.x); a[1] += bfhi(kv.x); a[2] += bflo(kv.y); a[3] += bfhi(kv.y); a[4] += bflo(kv.z); a[5] += bfhi(kv.z); a[6] += bflo(kv.w); a[7] += bfhi(kv.w); }
#pragma unroll
        for (int j = 0; j < 8; ++j) part[wave * 512 + lane * 8 + j] = a[j];
        __syncthreads();
        { const int col = tid; float s = 0.f;
#pragma unroll
          for (int w = 0; w < 8; ++w) s += part[w * 512 + col];
          kmean[(((size_t)b * MB_H + (col >> 6)) * MB_NB + n) * MB_D + (col & 63)] = s * (1.0f / MB_BS); }
        __syncthreads();
    }
}
__device__ __forceinline__ void phase_hgrn_naive(Frame& F, int l, float* oraw) {
    PHASE_IDS(F);
    const bf16* proj = (const bf16*)(ws + WS_BIG);
    const float* lbp = (const float*)(ws + WS_LB) + l * 512;
    LAS float* Qs = (LAS float*)(ldsb + RING_OFF);
    LAS float* Fs = Qs + 64 * 128; LAS float* Ks = Fs + 64 * 128; LAS float* Is = Ks + 64 * 128;
    for (int unit = bid; unit < BATCH * HG_H * 4; unit += G) {
        const int b = unit >> 4, h = (unit >> 2) & 3, vq = unit & 3;
        const int ds = tid & 15, vv = tid >> 4, d0 = ds * 8, v = vq * 32 + vv;
        float S[8];
#pragma unroll
        for (int j = 0; j < 8; ++j) S[j] = 0.f;
        for (int c = 0; c < SEQ / 64; ++c) {
            const size_t row0 = (size_t)b * SEQ + c * 64;
#pragma unroll
            for (int i = 0; i < 2; ++i) { const int vi = tid + 512 * i, t = vi >> 4, dd = (vi & 15) * 8;
                const v4u qv = *(const v4u*)(proj + (row0 + t) * DIN + C_HQ + h * HG_D + dd);
                const v4u fv = *(const v4u*)(proj + (row0 + t) * DIN + C_HF + h * HG_D + dd);
                float q[8], fl[8];
                q[0] = bflo(qv.x); q[1] = bfhi(qv.x); q[2] = bflo(qv.y); q[3] = bfhi(qv.y); q[4] = bflo(qv.z); q[5] = bfhi(qv.z); q[6] = bflo(qv.w); q[7] = bfhi(qv.w);
                fl[0] = bflo(fv.x); fl[1] = bfhi(fv.x); fl[2] = bflo(fv.y); fl[3] = bfhi(fv.y); fl[4] = bflo(fv.z); fl[5] = bfhi(fv.z); fl[6] = bflo(fv.w); fl[7] = bfhi(fv.w);
#pragma unroll
                for (int j = 0; j < 8; ++j) { const float lbv = lbp[h * HG_D + dd + j], sg = sigmoid_f(fl[j]);
                    Qs[t * 128 + dd + j] = q[j] * sigmoid_f(q[j]);
                    Fs[t * 128 + dd + j] = fmaxf(lbv + (1.0f - lbv) * sg, MIN_FORGET);
                    Ks[t * 128 + dd + j] = (1.0f - lbv) * (1.0f - sg); } }
            { const int t = tid >> 3, v4 = (tid & 7) * 4;
              const unsigned long long iv = *(const unsigned long long*)(proj + (row0 + t) * DIN + C_HI + h * HG_D + vq * 32 + v4);
              const unsigned lo = (unsigned)iv, hi = (unsigned)(iv >> 32);
              Is[t * 32 + v4 + 0] = bflo(lo); Is[t * 32 + v4 + 1] = bfhi(lo); Is[t * 32 + v4 + 2] = bflo(hi); Is[t * 32 + v4 + 3] = bfhi(hi); }
            __syncthreads();
            for (int t = 0; t < 64; ++t) {
                const float iv = Is[t * 32 + vv];
                const f32x4 f0 = *(const LAS f32x4*)&Fs[t * 128 + d0], f1 = *(const LAS f32x4*)&Fs[t * 128 + d0 + 4];
                const f32x4 k0 = *(const LAS f32x4*)&Ks[t * 128 + d0], k1 = *(const LAS f32x4*)&Ks[t * 128 + d0 + 4];
                const f32x4 q0 = *(const LAS f32x4*)&Qs[t * 128 + d0], q1 = *(const LAS f32x4*)&Qs[t * 128 + d0 + 4];
                float acc = 0.f;
#pragma unroll
                for (int j = 0; j < 4; ++j) { S[j] = f0[j] * S[j] + k0[j] * iv; acc += q0[j] * S[j]; S[4 + j] = f1[j] * S[4 + j] + k1[j] * iv; acc += q1[j] * S[4 + j]; }
                acc += __shfl_xor(acc, 1); acc += __shfl_xor(acc, 2); acc += __shfl_xor(acc, 4); acc += __shfl_xor(acc, 8);
                if (ds == 0) oraw[(row0 + t) * HG_W + h * HG_D + v] = acc;
            }
            __syncthreads();
        }
    }
}
__device__ __forceinline__ void phase_hgrn_finish(Frame& F, const float* oraw, const float* normw) {
    PHASE_IDS(F);
    bf16* proj = (bf16*)(ws + WS_BIG);
    const int gw = bid * NWAVES + wave, NGW = G * NWAVES;
    float w[8];
#pragma unroll
    for (int j = 0; j < 8; ++j) w[j] = normw[(lane & 15) * 8 + j];
    for (int m = gw; m < MROWS; m += NGW) {
        const f32x4 o0 = *(const f32x4*)(oraw + (size_t)m * HG_W + lane * 8), o1 = *(const f32x4*)(oraw + (size_t)m * HG_W + lane * 8 + 4);
        bf16* gp = proj + (size_t)m * DIN + C_HG + lane * 8;
        const v4u gv = *(const v4u*)gp;
        float ss = (o0.x * o0.x + o0.y * o0.y) + (o0.z * o0.z + o0.w * o0.w) + (o1.x * o1.x + o1.y * o1.y) + (o1.z * o1.z + o1.w * o1.w);
        ss += __shfl_xor(ss, 1); ss += __shfl_xor(ss, 2); ss += __shfl_xor(ss, 4); ss += __shfl_xor(ss, 8);
        const float r = 1.0f / sqrtf(ss * (1.0f / HG_D) + NORM_EPS);
        float g[8], o[8];
        g[0] = bflo(gv.x); g[1] = bfhi(gv.x); g[2] = bflo(gv.y); g[3] = bfhi(gv.y); g[4] = bflo(gv.z); g[5] = bfhi(gv.z); g[6] = bflo(gv.w); g[7] = bfhi(gv.w);
        o[0] = o0.x; o[1] = o0.y; o[2] = o0.z; o[3] = o0.w; o[4] = o1.x; o[5] = o1.y; o[6] = o1.z; o[7] = o1.w;
#pragma unroll
        for (int j = 0; j < 8; ++j) o[j] = o[j] * r * w[j] * (g[j] * sigmoid_f(g[j]));
        v4u ov; ov.x = pk2(o[0], o[1]); ov.y = pk2(o[2], o[3]); ov.z = pk2(o[4], o[5]); ov.w = pk2(o[6], o[7]);
        *(v4u*)gp = ov;
    }
}
__device__ __forceinline__ void phase_moba_naive(Frame& F) {
    PHASE_IDS(F);
    bf16* proj = (bf16*)(ws + WS_BIG);
    const float* kmean = (const float*)(ws + WS_KMEAN);
    LAS float* qs = (LAS float*)(ldsb + RING_OFF) + wave * 64;
    const int gw = bid * NWAVES + wave, NGW = G * NWAVES;
    for (int task = gw; task < MROWS * MB_H; task += NGW) {
        const int row = task >> 3, h = task & 7, b = row >> 12, tpos = row & (SEQ - 1), qb = tpos >> 8;
        bf16* qp = proj + (size_t)row * DIN + C_MQ + h * MB_D;
        const float qv = bf1(qp[lane]);
        qs[lane] = qv;
        LDS_WAIT(); asm volatile("" ::: "memory");
        const float slope = exp2f(-(float)(h + 1));
        float g = -INFINITY;
        for (int n = 0; n < qb; ++n) { const float p = wave_sum(qv * kmean[(((size_t)b * MB_H + h) * MB_NB + n) * MB_D + lane]); if (lane == n) g = p; }
        const int nsel = qb < 3 ? qb : 3;
        int s0 = 0, s1 = 0, s2 = 0;
#pragma unroll
        for (int r = 0; r < 3; ++r) if (r < nsel) {
            const float mx = wave_max(g);
            const unsigned long long bal = __ballot(g == mx);
            const int idx = __ffsll((long long)bal) - 1;
            if (r == 0) s0 = idx; else if (r == 1) s1 = idx; else s2 = idx;
            if (lane == idx) g = -INFINITY;
        }
        float m = -INFINITY, lsum = 0.f, o = 0.f;
        for (int bi = 0; bi <= nsel; ++bi) {
            const bool own = (bi == nsel);
            const int blk = own ? qb : (bi == 0 ? s0 : (bi == 1 ? s1 : s2));
            for (int kt = 0; kt < 4; ++kt) {
                const int kstart = blk * MB_BS + kt * 64;
                if (own && kstart > tpos) break;
                const int kp = kstart + lane;
                const bf16* krow = proj + ((size_t)b * SEQ + kp) * DIN + C_MK + h * MB_D;
                float dot = 0.f;
#pragma unroll
                for (int c = 0; c < 8; ++c) { const v4u kv = *(const v4u*)(krow + c * 8);
                    const f32x4 qa = *(const LAS f32x4*)&qs[c * 8], qc = *(const LAS f32x4*)&qs[c * 8 + 4];
                    dot += bflo(kv.x) * qa.x + bfhi(kv.x) * qa.y + bflo(kv.y) * qa.z + bfhi(kv.y) * qa.w + bflo(kv.z) * qc.x + bfhi(kv.z) * qc.y + bflo(kv.w) * qc.z + bfhi(kv.w) * qc.w; }
                float s = dot * 0.125f - slope * fabsf((float)(tpos - kp));
                if (own && kp > tpos) s = -INFINITY;
                const float mn = fmaxf(m, wave_max(s));
                const float p = exp2f((s - mn) * LOG2E), corr = exp2f((m - mn) * LOG2E);
                lsum = lsum * corr + wave_sum(p); o *= corr; m = mn;
                const bf16* vcol = proj + ((size_t)b * SEQ + kstart) * DIN + C_MV + h * MB_D + lane;
#pragma unroll
                for (int j = 0; j < 64; ++j) { const float pj = __uint_as_float(__builtin_amdgcn_readlane(__float_as_uint(p), j)); o += pj * bf1(vcol[(size_t)j * DIN]); }
            }
        }
        qp[lane] = (bf16)f2bf(o / lsum);
    }
}

struct Args { const float* in[15]; float* out; unsigned char* ws; };
__global__ void __launch_bounds__(NWAVES * 64, 2) fwd_kernel(Args args) {
    extern __shared__ __attribute__((aligned(16))) unsigned char lds[];
    Frame F;
    F.lds = (LAS unsigned char*)lds;
    F.MISC = (volatile LAS unsigned*)(F.lds + MISC_OFF);
    F.tid = threadIdx.x; F.lane = F.tid & 63; F.wave = __builtin_amdgcn_readfirstlane(F.tid >> 6);
    F.G = gridDim.x; F.ws = args.ws; F.xo = args.out;
    F.ctl = (gu32*)(args.ws + WS_CTL);
    for (int u = F.tid; u < (LDS_BYTES - LDSCTL_OFF) / 4; u += NWAVES * 64) ((LAS unsigned*)(F.lds + LDSCTL_OFF))[u] = 0u;
    __syncthreads();
    XcdBarrier bar = xcd_barrier_post((unsigned*)(F.ctl + CW_BAR), F.MISC + 8);
#define GRID_BAR() xcd_barrier(bar)
    unsigned char* ws = args.ws;
    bf16* Hb = (bf16*)(ws + WS_H);
    bf16* BIG = (bf16*)(ws + WS_BIG);
    float* oraw = (float*)(ws + WS_H);
    const bf16* wb = (const bf16*)(ws + WS_W);
    compute_lb(F, args.in[6]);

    for (int l = 0; l < DEPTH; ++l) {
        const float* xsrc = (l == 0) ? args.in[0] : (const float*)F.xo;
        phase_convert(F, args.in, l);
        phase_rmsnorm_bf16(F, xsrc, args.in[1] + l * DM, Hb);
        GRID_BAR();
        { pg8::Gemm g{Hb, (const bf16*)((const unsigned char*)wb + W_GU1), MROWS, 2 * DFF, DM, DM}; pg8::StaticOrderC<MROWS, 2 * DFF> S; S.init(F.G, (int)blockIdx.x);
          pg8::EpiSwiGLU E{BIG, DFF};
          pg8::gemm_phase<pg8::EpiSwiGLU, pg8::StaticOrderC<MROWS, 2 * DFF>, true, true, DM, DM>(F.lds + RING_OFF, g, S, E); }
        GRID_BAR();
        { pg8::Gemm g{BIG, (const bf16*)((const unsigned char*)wb + W_DN1), MROWS, DM, DFF, DFF}; pg8::StaticOrderC<MROWS, DM> S; S.init(F.G, (int)blockIdx.x);
          pg8::EpiResid E{xsrc, F.xo, DM, 0.5f};
          pg8::gemm_phase<pg8::EpiResid, pg8::StaticOrderC<MROWS, DM>, true, true, DFF, DFF>(F.lds + RING_OFF, g, S, E); }
        GRID_BAR();
        phase_rmsnorm_bf16(F, F.xo, args.in[4] + l * DM, Hb);
        GRID_BAR();
        { pg8::Gemm g{Hb, (const bf16*)((const unsigned char*)wb + W_IN), MROWS, DIN, DM, DM}; pg8::StaticOrderC<MROWS, DIN> S; S.init(F.G, (int)blockIdx.x);
          pg8::EpiStoreBf16 E{BIG, DIN};
          pg8::gemm_phase<pg8::EpiStoreBf16, pg8::StaticOrderC<MROWS, DIN>, true, true, DM, DM>(F.lds + RING_OFF, g, S, E); }
        GRID_BAR();
        phase_kmean(F);
        phase_hgrn_naive(F, l, oraw);
        GRID_BAR();
        phase_moba_naive(F);
        phase_hgrn_finish(F, oraw, args.in[7] + l * HG_D);
        GRID_BAR();
        { pg8::Gemm g{BIG + C_HG, (const bf16*)((const unsigned char*)wb + W_A), MROWS, DM, 512, DIN}; pg8::StaticOrderC<MROWS, DM> S; S.init(F.G, (int)blockIdx.x);
          pg8::EpiGate<0> E{BIG + C_GA, DIN, nullptr, 0, BIG, DIN};
          pg8::gemm_phase<pg8::EpiGate<0>, pg8::StaticOrderC<MROWS, DM>, true, true, 512, DIN>(F.lds + RING_OFF, g, S, E); }
        GRID_BAR();
        { pg8::Gemm g{BIG + C_MQ, (const bf16*)((const unsigned char*)wb + W_B), MROWS, DM, 512, DIN}; pg8::StaticOrderC<MROWS, DM> S; S.init(F.G, (int)blockIdx.x);
          pg8::EpiGate<1> E{BIG + C_GB, DIN, BIG, DIN, Hb, DM};
          pg8::gemm_phase<pg8::EpiGate<1>, pg8::StaticOrderC<MROWS, DM>, true, true, 512, DIN>(F.lds + RING_OFF, g, S, E); }
        GRID_BAR();
        { pg8::Gemm g{Hb, (const bf16*)((const unsigned char*)wb + W_OUT), MROWS, DM, DM, DM}; pg8::StaticOrderC<MROWS, DM> S; S.init(F.G, (int)blockIdx.x);
          pg8::EpiResid E{F.xo, F.xo, DM, 1.0f};
          pg8::gemm_phase<pg8::EpiResid, pg8::StaticOrderC<MROWS, DM>, true, true, DM, DM>(F.lds + RING_OFF, g, S, E); }
        GRID_BAR();
        phase_rmsnorm_bf16(F, F.xo, args.in[11] + l * DM, Hb);
        GRID_BAR();
        { pg8::Gemm g{Hb, (const bf16*)((const unsigned char*)wb + W_GU2), MROWS, 2 * DFF, DM, DM}; pg8::StaticOrderC<MROWS, 2 * DFF> S; S.init(F.G, (int)blockIdx.x);
          pg8::EpiSwiGLU E{BIG, DFF};
          pg8::gemm_phase<pg8::EpiSwiGLU, pg8::StaticOrderC<MROWS, 2 * DFF>, true, true, DM, DM>(F.lds + RING_OFF, g, S, E); }
        GRID_BAR();
        { pg8::Gemm g{BIG, (const bf16*)((const unsigned char*)wb + W_DN2), MROWS, DM, DFF, DFF}; pg8::StaticOrderC<MROWS, DM> S; S.init(F.G, (int)blockIdx.x);
          pg8::EpiResid E{F.xo, F.xo, DM, 0.5f};
          pg8::gemm_phase<pg8::EpiResid, pg8::StaticOrderC<MROWS, DM>, true, true, DFF, DFF>(F.lds + RING_OFF, g, S, E); }
        GRID_BAR();
    }
    phase_rmsnorm_f32(F, F.xo, args.in[14]);
}

extern "C" void kernel_launch(void* const* d_in, const int* in_sizes, int n_in, void* d_out, int out_size, void* d_ws, size_t ws_size, hipStream_t stream) {
    static int grid = 0;
    if (grid == 0) {
        if (n_in != 15 || in_sizes[0] != MROWS * DM || out_size != MROWS * DM || ws_size < WS_END) { fprintf(stderr, "kernel_launch: unexpected shapes (n_in %d, in0 %d, out %d, ws %zu; need ws >= %zu); nothing launched\n", n_in, n_in > 0 ? in_sizes[0] : -1, out_size, ws_size, (size_t)WS_END); grid = -1; return; }
        int dev = 0, cus = 0, per_cu = 0;
        if (hipGetDevice(&dev) != hipSuccess || hipDeviceGetAttribute(&cus, hipDeviceAttributeMultiprocessorCount, dev) != hipSuccess) { grid = -1; return; }
        if (hipFuncSetAttribute((const void*)fwd_kernel, hipFuncAttributeMaxDynamicSharedMemorySize, LDS_BYTES) != hipSuccess) { fprintf(stderr, "kernel_launch: hipFuncSetAttribute failed\n"); grid = -1; return; }
        if (hipOccupancyMaxActiveBlocksPerMultiprocessor(&per_cu, (const void*)fwd_kernel, NWAVES * 64, LDS_BYTES) != hipSuccess || per_cu < 1)
            fprintf(stderr, "kernel_launch: note: occupancy query reports %d workgroups per CU\n", per_cu);
        (void)hipGetLastError();
        grid = cus;
    }
    if (grid < 0) return;
    if (hipMemsetAsync((char*)d_ws + WS_CTL, 0, CTL_ZERO_BYTES, stream) != hipSuccess) { fprintf(stderr, "kernel_launch: memset failed\n"); return; }
    Args a{};
    for (int i = 0; i < 15; ++i) a.in[i] = (const float*)d_in[i];
    a.out = (float*)d_out; a.ws = (unsigned char*)d_ws;
    hipLaunchKernelGGL(fwd_kernel, dim3(grid), dim3(NWAVES * 64), LDS_BYTES, stream, a);
}
```

```cpp
#include <hip/hip_runtime.h>
#include <cstdio>
#include <cstdint>
namespace pg8 {
#define PG8_LAS __attribute__((address_space(3)))
typedef unsigned short bf16_t;
typedef short bf16x8 __attribute__((ext_vector_type(8)));
typedef float f32x4 __attribute__((ext_vector_type(4)));
typedef unsigned u32x4 __attribute__((ext_vector_type(4)));
constexpr int BM = 256, BK = 64, HALF = 128, HTB = HALF * BK * 2  , STAGE_BYTES = 8 * HTB, NXCD = 8, WGM = 8;

__host__ __device__ __forceinline__ int lds_byte(int r, int c) { const int st = (r >> 4) * 2 + (c >> 5), rr = r & 15, cc = c & 31, ob = rr * 64 + cc * 2; return st * 1024 + (ob ^ (((ob >> 9) & 1) << 5)); }
__host__ __device__ __forceinline__ void stage_rc(int b, int& R, int& C) { const int st = b / 1024, sb = b % 1024, swz = sb ^ (((sb >> 9) & 1) << 5); R = (st >> 1) * 16 + swz / 64; C = (st & 1) * 32 + (swz % 64) / 2; }
__host__ __device__ __forceinline__ int perm32(int rho) { const int n = rho >> 4, i = rho & 15; return 8 * (i >> 2) + 4 * n + (i & 3); }

struct Unit { int pm, pn; };
struct Gemm { const bf16_t* A; const bf16_t* Bt; int M, N, K, lda; };

struct StaticOrder {
    int nM, nN, nwg, G, c;
    __host__ __device__ void init(int M, int N, int G_, int c_) { nM = M / BM; nN = N / BM; nwg = nM * nN; G = G_; c = c_; }
    __host__ __device__ bool next(int i, Unit& u) const {
        const long L = (long)i * G + c; if (L >= nwg) return false;
        int wgid = (int)L; { const int q = nwg / NXCD, r = nwg % NXCD, xcd = wgid % NXCD, off = wgid / NXCD; wgid = (xcd < r ? xcd * (q + 1) : r * (q + 1) + (xcd - r) * q) + off; }
        const int nig = WGM * nN, gid = wgid / nig, fm = gid * WGM, gsz = (nM - fm) < WGM ? (nM - fm) : WGM;
        u.pm = fm + ((wgid % nig) % gsz); u.pn = (wgid % nig) / gsz; return true;
    }
    __device__ __forceinline__ void a_ready(const Unit&) const {}
    __device__ __forceinline__ void done(const Unit&) const {}
};

__device__ __forceinline__ unsigned cvt_pk_bf16(float lo, float hi) { unsigned r; asm volatile("v_cvt_pk_bf16_f32 %0, %1, %2" : "=v"(r) : "v"(lo), "v"(hi)); return r; }
typedef float f32x2 __attribute__((ext_vector_type(2)));
__device__ __forceinline__ float bf_lo(unsigned u) { return __uint_as_float(u << 16); }
__device__ __forceinline__ float bf_hi(unsigned u) { return __uint_as_float(u & 0xffff0000u); }
__device__ __forceinline__ float sigm(float x) { return __builtin_amdgcn_rcpf(1.0f + __builtin_amdgcn_exp2f(x * -1.4426950408889634f)); }

__device__ __forceinline__ size_t img_off(int row, int col, int Kc) { return ((size_t)(row >> 7) * (Kc >> 6) + (col >> 6)) * 16384 + (size_t)lds_byte(row & 127, col & 63); }
__device__ __forceinline__ size_t gimg_off(int pm, int pn, int type, int ai, int m, int bj, int wid, int lane) {
    return ((((((((size_t)pm * 4 + pn) * 2 + type) * 2 + ai) * 4 + m) * 2 + bj) * 8 + wid) * 64 + lane) * 16; }
struct PreNone {};
struct PreRow { unsigned long long a, b; };
__device__ __forceinline__ PreRow pre_rows(const unsigned long long* ss, const Unit& u, int wr, int fr, int fq) { const int r = u.pm * BM + wr * 64 + fr + (fq >> 1) * HALF + (fq & 1) * 32; return PreRow{ss[r], ss[r + 16]}; }
__device__ __forceinline__ float pre_get(const PreRow& p, int ai, int m, int fr) { const unsigned long long v = (m & 1) ? p.b : p.a; const int src = fr + 16 * (ai * 2 + (m >> 1));
    const unsigned lo = (unsigned)__shfl((int)(unsigned)v, src), hi = (unsigned)__shfl((int)(unsigned)(v >> 32), src);
    return (float)(((unsigned long long)hi << 32) | lo) * (1.0f / 16777216.0f); }
#if defined(EPI_NT_STORES)
#define EPI_ST16(p, v) __builtin_nontemporal_store((v), (u32x4*)(p))
#else
#define EPI_ST16(p, v) (*(u32x4*)(p) = (v))
#endif
struct EpiStoreBf16 {
    static constexpr bool PERM = true, AFTER_DRAIN = false; static constexpr int MID_T = 0;
    unsigned char* big; int pn_lo, pn_hi; float scale; const unsigned long long* ss; int pn_k, pn_v; unsigned char* kimg; unsigned char* vimg; int seq;
    typedef PreRow Pre;
    __device__ __forceinline__ Pre prefetch(const Unit& u, int wr, int fr, int fq) const { return pre_rows(ss, u, wr, fr, fq); }
    __device__ __forceinline__ void operator()(const f32x4 (&acc)[2][2][4][2], const Unit& u, int wr, int wc, int fr, int fq, const Pre& pre) const {
        const int row0 = u.pm * BM + wr * 64 + fr, col0 = u.pn * BM + wc * 32 + 8 * fq;
        const float sc0 = (u.pn >= pn_lo && u.pn < pn_hi) ? scale : 1.0f;
        float rs[2][4];
#pragma unroll
        for (int ai = 0; ai < 2; ++ai)
#pragma unroll
            for (int m = 0; m < 4; ++m) rs[ai][m] = pre_get(pre, ai, m, fr);
        const int kv_kind = (u.pn >= pn_k && u.pn < pn_k + 2) ? 1 : ((u.pn >= pn_v && u.pn < pn_v + 2) ? 2 : 0);
#pragma unroll
        for (int ai = 0; ai < 2; ++ai)
#pragma unroll
            for (int m = 0; m < 4; ++m) { const int row = row0 + ai * HALF + m * 16;
                const float sc = sc0 * __builtin_amdgcn_rsqf(rs[ai][m] * (1.0f / 1024.0f) + 1e-6f);
                const int b = row / seq, pos = row - b * seq, t = pos >> 6, kv = pos & 63;
#pragma unroll
                for (int bj = 0; bj < 2; ++bj) { const f32x4 v0 = acc[ai][bj][m][0] * sc, v1 = acc[ai][bj][m][1] * sc;
                    u32x4 w; w.x = cvt_pk_bf16(v0[0], v0[1]); w.y = cvt_pk_bf16(v0[2], v0[3]); w.z = cvt_pk_bf16(v1[0], v1[1]); w.w = cvt_pk_bf16(v1[2], v1[3]);
                    if (kv_kind == 0) { const int cg = u.pn * BM + bj * HALF + wc * 32 + 8 * fq;
                        if (u.pn < 8) { const int which = cg >> 9, hh = (cg >> 7) & 3, dd = cg & 127;
                            *(u32x4*)(big + (size_t)which * (32u << 20) + (((size_t)(b * 4 + hh) * seq + pos) * 128 + dd) * 2) = w; }
                        else if (u.pn < 10) *(u32x4*)(big + (size_t)(128u << 20) + ((size_t)row * 512 + (cg - 2048)) * 2) = w;
                        else { unsigned go_ = (unsigned)((ai * 4 + m) * 16384 + bj * 8192); asm volatile("" : "+v"(go_));
                            *(u32x4*)(big + (size_t)(160u << 20) + gimg_off(u.pm, (u.pn - 14) & 3, (u.pn - 14) >> 2, 0, 0, 0, wr * 4 + wc, fr + 16 * fq) + go_) = w; } }
                    else { const int cl = (u.pn - (kv_kind == 1 ? pn_k : pn_v)) * BM + bj * HALF + wc * 32 + 8 * fq, h = cl >> 6, d = cl & 63;
                        const size_t tile = ((size_t)(b * 8 + h) * (seq >> 6) + t) * 8192;
                        if (kv_kind == 1) *(u32x4*)(kimg + tile + (d >> 3) * 1024 + kv * 16) = w;
                        else *(u32x4*)(vimg + tile + ((d >> 5) * 4 + (kv >> 4)) * 1024 + (kv & 15) * 64 + ((d & 31) >> 3) * 16) = w; } } }
    }
};
struct EpiSwiGLU {
    static constexpr bool PERM = true, AFTER_DRAIN = false; static constexpr int MID_T = 0;
    bf16_t* O; int ldc; const unsigned long long* ss; unsigned char* dummy;
    typedef PreRow Pre;
    __device__ __forceinline__ Pre prefetch(const Unit& u, int wr, int fr, int fq) const { return pre_rows(ss, u, wr, fr, fq); }
    __device__ __forceinline__ void operator()(const f32x4 (&acc)[2][2][4][2], const Unit& u, int wr, int wc, int fr, int fq, const Pre& pre) const {
        const int row0 = u.pm * BM + wr * 64 + fr, col0 = u.pn * HALF + wc * 32 + 8 * fq;
        float rs[2][4];
#pragma unroll
        for (int ai = 0; ai < 2; ++ai)
#pragma unroll
            for (int m = 0; m < 4; ++m) rs[ai][m] = pre_get(pre, ai, m, fr);
#pragma unroll
        for (int ai = 0; ai < 2; ++ai)
#pragma unroll
            for (int m = 0; m < 4; ++m) { bf16_t* rowp = (bf16_t*)((unsigned char*)O + img_off(row0 + ai * HALF + m * 16, col0, ldc));
                if (dummy) rowp = (bf16_t*)(dummy + (size_t)blockIdx.x * 16384 + (img_off(row0 + ai * HALF + m * 16, col0, ldc) & 16383));
                const float rr = __builtin_amdgcn_rsqf(rs[ai][m] * (1.0f / 1024.0f) + 1e-6f), rr2 = rr * rr, rrl = rr * -1.4426950408889634f;
                float a[8];
#pragma unroll
                for (int n = 0; n < 2; ++n)
#pragma unroll
                    for (int e = 0; e < 4; ++e) { const float ag = acc[ai][0][m][n][e], au = acc[ai][1][m][n][e];
                        a[n * 4 + e] = (ag * au) * (rr2 * __builtin_amdgcn_rcpf(1.0f + __builtin_amdgcn_exp2f(ag * rrl))); }
                u32x4 w; w.x = cvt_pk_bf16(a[0], a[1]); w.y = cvt_pk_bf16(a[2], a[3]); w.z = cvt_pk_bf16(a[4], a[5]); w.w = cvt_pk_bf16(a[6], a[7]);
                EPI_ST16(rowp, w); }
    }
};
struct EpiResid {
    static constexpr bool PERM = true, AFTER_DRAIN = false; static constexpr int MID_T = 0;
    bf16_t* xb; int ldc; float scale; unsigned long long* ss; PG8_LAS float* racc; PG8_LAS unsigned* rcnt; bool nosum;
    typedef PreNone Pre;
    __device__ __forceinline__ Pre prefetch(const Unit&, int, int, int) const { return Pre{}; }
    __device__ __forceinline__ void operator()(const f32x4 (&acc)[2][2][4][2], const Unit& u, int wr, int wc, int fr, int fq, const Pre&) const {
        const int row0 = u.pm * BM + wr * 64 + fr, col0 = u.pn * BM + wc * 32 + 8 * fq;
#pragma unroll
        for (int ai = 0; ai < 2; ++ai) {
            u32x4 xv[4][2];
#pragma unroll
            for (int m = 0; m < 4; ++m)
#pragma unroll
                for (int bj = 0; bj < 2; ++bj) xv[m][bj] = *(const u32x4*)((const unsigned char*)xb + img_off(row0 + ai * HALF + m * 16, col0 + bj * HALF, ldc));
            float sqm[4];
#pragma unroll
            for (int m = 0; m < 4; ++m) { const int row = row0 + ai * HALF + m * 16; float sq = 0.f;
#pragma unroll
                for (int bj = 0; bj < 2; ++bj) { const u32x4 bv = xv[m][bj];
                    const f32x4 a0 = acc[ai][bj][m][0] * scale, a1 = acc[ai][bj][m][1] * scale;
                    const float v0 = bf_lo(bv.x) + a0[0], v1 = bf_hi(bv.x) + a0[1], v2 = bf_lo(bv.y) + a0[2], v3 = bf_hi(bv.y) + a0[3];
                    const float v4 = bf_lo(bv.z) + a1[0], v5 = bf_hi(bv.z) + a1[1], v6 = bf_lo(bv.w) + a1[2], v7 = bf_hi(bv.w) + a1[3];
                    sq += (v0 * v0 + v1 * v1) + (v2 * v2 + v3 * v3) + (v4 * v4 + v5 * v5) + (v6 * v6 + v7 * v7);
                    u32x4 w; w.x = cvt_pk_bf16(v0, v1); w.y = cvt_pk_bf16(v2, v3); w.z = cvt_pk_bf16(v4, v5); w.w = cvt_pk_bf16(v6, v7);
                    *(u32x4*)((unsigned char*)xb + img_off(row, col0 + bj * HALF, ldc)) = w; }
                sq += __shfl_xor(sq, 16); sq += __shfl_xor(sq, 32); sqm[m] = sq; }
            if (!nosum) {
#pragma unroll
                for (int m = 0; m < 4; ++m) if (fq == 0) racc[((ai * 8 + wr * 4 + m) * 16 + fr) * 4 + wc] = sqm[m];
                asm volatile("s_waitcnt lgkmcnt(0)" ::: "memory");
                const int cg = ai * 2 + wr;
                unsigned old = 0u; if (fr == 0 && fq == 0) old = __hip_atomic_fetch_add(rcnt + cg, 1u, __ATOMIC_RELAXED, __HIP_MEMORY_SCOPE_WORKGROUP);
                old = (unsigned)__builtin_amdgcn_readfirstlane(old);
                if (old == 3u) { const int grp = ai * 8 + wr * 4 + fq; const f32x4 p4 = *(const PG8_LAS f32x4*)(racc + (grp * 16 + fr) * 4); const float tot = ((p4[0] + p4[1]) + p4[2]) + p4[3];
                    if (ss) (void)__hip_atomic_fetch_add(ss + (row0 + ai * HALF + fq * 16), (unsigned long long)(tot * 16777216.0f), __ATOMIC_RELAXED, __HIP_MEMORY_SCOPE_AGENT);
                    if (fr == 0 && fq == 0) rcnt[cg] = 0u; } }
            asm volatile("" ::: "memory"); }
    }
};
template <int MODE> struct EpiGate {
    static constexpr bool PERM = true, AFTER_DRAIN = false; static constexpr int MID_T = 0;
    const bf16_t* G; int ldg; const bf16_t* P; int ldp; bf16_t* O; int ldo;
    typedef PreNone Pre;
    __device__ __forceinline__ Pre prefetch(const Unit&, int, int, int) const { return Pre{}; }
    __device__ __forceinline__ void operator()(const f32x4 (&acc)[2][2][4][2], const Unit& u, int wr, int wc, int fr, int fq, const Pre&) const {
        const int row0 = u.pm * BM + wr * 64 + fr, col0 = u.pn * BM + wc * 32 + 8 * fq;
#pragma unroll
        for (int ai = 0; ai < 2; ++ai)
#pragma unroll
            for (int m = 0; m < 4; ++m) { const size_t row = (size_t)(row0 + ai * HALF + m * 16);
#pragma unroll
                for (int bj = 0; bj < 2; ++bj) { const int c = col0 + bj * HALF;
                    const u32x4 gv = *(const u32x4*)(G + row * ldg + c);
                    const f32x4 v0 = acc[ai][bj][m][0], v1 = acc[ai][bj][m][1];
                    float a[8];
                    a[0] = sigm(bf_lo(gv.x)) * v0[0]; a[1] = sigm(bf_hi(gv.x)) * v0[1]; a[2] = sigm(bf_lo(gv.y)) * v0[2]; a[3] = sigm(bf_hi(gv.y)) * v0[3];
                    a[4] = sigm(bf_lo(gv.z)) * v1[0]; a[5] = sigm(bf_hi(gv.z)) * v1[1]; a[6] = sigm(bf_lo(gv.w)) * v1[2]; a[7] = sigm(bf_hi(gv.w)) * v1[3];
                    if (MODE == 1) { const u32x4 pv = *(const u32x4*)(P + row * ldp + c);
                        a[0] += bf_lo(pv.x); a[1] += bf_hi(pv.x); a[2] += bf_lo(pv.y); a[3] += bf_hi(pv.y); a[4] += bf_lo(pv.z); a[5] += bf_hi(pv.z); a[6] += bf_lo(pv.w); a[7] += bf_hi(pv.w); }
                    u32x4 w; w.x = cvt_pk_bf16(a[0], a[1]); w.y = cvt_pk_bf16(a[2], a[3]); w.z = cvt_pk_bf16(a[4], a[5]); w.w = cvt_pk_bf16(a[6], a[7]);
                    *(u32x4*)(O + row * ldo + c) = w; }
                asm volatile("" ::: "memory"); }
    }
};

struct EpiGateMerge {
    static constexpr bool PERM = true, AFTER_DRAIN = false; static constexpr int MID_T = 8;
    const unsigned char* gimg; bf16_t* O; int ldo;
    typedef PreNone Pre;
    __device__ __forceinline__ Pre prefetch(const Unit&, int, int, int) const { return Pre{}; }
    __device__ __forceinline__ void mid(f32x4 (&acc)[2][2][4][2], const Unit& u, int wr, int wc, int fr, int fq) const {
        const int row0 = u.pm * BM + wr * 64 + fr, col0 = u.pn * BM + wc * 32 + 8 * fq;
        u32x4 ga[2][2][2], gb[2][2][2];
        const unsigned char* gl = gimg + gimg_off(u.pm, u.pn, 0, 0, 0, 0, wr * 4 + wc, fr + 16 * fq);
#define EGM_LOAD(B, SLOT) do { unsigned bo_ = (unsigned)((((B) >> 1) * 4 + ((B) & 1) * 2) * 16384); asm volatile("" : "+v"(bo_));     \
            const unsigned char* pb_ = gl + bo_; \
            _Pragma("unroll") for (int mm = 0; mm < 2; ++mm) _Pragma("unroll") for (int bj = 0; bj < 2; ++bj) { \
                ga[SLOT][mm][bj] = *(const u32x4*)(pb_ + mm * 16384 + bj * 8192); gb[SLOT][mm][bj] = *(const u32x4*)(pb_ + 131072 + mm * 16384 + bj * 8192); } } while (0)
        EGM_LOAD(0, 0);
#pragma unroll
        for (int b = 0; b < 4; ++b) { const int ai = b >> 1, mp = b & 1, sl = b & 1;
            if (b == 0) { EGM_LOAD(1, 1); } else if (b == 1) { EGM_LOAD(2, 0); } else if (b == 2) { EGM_LOAD(3, 1); }
#pragma unroll
            for (int mm = 0; mm < 2; ++mm)
#pragma unroll
                for (int bj = 0; bj < 2; ++bj) { const u32x4 a4 = ga[sl][mm][bj], b4 = gb[sl][mm][bj];
                    const float ea[8] = {bf_lo(a4.x), bf_hi(a4.x), bf_lo(a4.y), bf_hi(a4.y), bf_lo(a4.z), bf_hi(a4.z), bf_lo(a4.w), bf_hi(a4.w)};
                    const float eb[8] = {bf_lo(b4.x), bf_hi(b4.x), bf_lo(b4.y), bf_hi(b4.y), bf_lo(b4.z), bf_hi(b4.z), bf_lo(b4.w), bf_hi(b4.w)};
#pragma unroll
                    for (int e8 = 0; e8 < 8; ++e8) { const float rho = (1.0f + __builtin_amdgcn_exp2f(eb[e8] * -1.4426950408889634f)) * __builtin_amdgcn_rcpf(1.0f + __builtin_amdgcn_exp2f(ea[e8] * -1.4426950408889634f));
                        acc[ai][bj][mp * 2 + mm][e8 >> 2][e8 & 3] *= rho; } }
            asm volatile("" ::: "memory"); }
#undef EGM_LOAD
    }
    __device__ __forceinline__ void operator()(const f32x4 (&acc)[2][2][4][2], const Unit& u, int wr, int wc, int fr, int fq, const Pre&) const {
        const int row0 = u.pm * BM + wr * 64 + fr, col0 = u.pn * BM + wc * 32 + 8 * fq;
#pragma unroll
        for (int ai = 0; ai < 2; ++ai) { unsigned rowv = (unsigned)(row0 + ai * HALF); asm volatile("" : "+v"(rowv));
            unsigned bo_ = (unsigned)(131072 + ai * 65536); asm volatile("" : "+v"(bo_));
            const unsigned char* pb_ = gimg + gimg_off(u.pm, u.pn, 0, 0, 0, 0, wr * 4 + wc, fr + 16 * fq) + bo_;
            u32x4 gb[4][2];
#pragma unroll
            for (int m = 0; m < 4; ++m)
#pragma unroll
                for (int bj = 0; bj < 2; ++bj) gb[m][bj] = *(const u32x4*)(pb_ + m * 16384 + bj * 8192);
#pragma unroll
            for (int m = 0; m < 4; ++m)
#pragma unroll
                for (int bj = 0; bj < 2; ++bj) { const u32x4 gv = gb[m][bj];
                    const f32x4 v0 = acc[ai][bj][m][0], v1 = acc[ai][bj][m][1];
                    float a[8];
                    a[0] = sigm(bf_lo(gv.x)) * v0[0]; a[1] = sigm(bf_hi(gv.x)) * v0[1]; a[2] = sigm(bf_lo(gv.y)) * v0[2]; a[3] = sigm(bf_hi(gv.y)) * v0[3];
                    a[4] = sigm(bf_lo(gv.z)) * v1[0]; a[5] = sigm(bf_hi(gv.z)) * v1[1]; a[6] = sigm(bf_lo(gv.w)) * v1[2]; a[7] = sigm(bf_hi(gv.w)) * v1[3];
                    u32x4 w; w.x = cvt_pk_bf16(a[0], a[1]); w.y = cvt_pk_bf16(a[2], a[3]); w.z = cvt_pk_bf16(a[4], a[5]); w.w = cvt_pk_bf16(a[6], a[7]);
                    *(u32x4*)((unsigned char*)O + img_off((int)rowv + m * 16, col0 + bj * HALF, ldo)) = w; }
            asm volatile("" ::: "memory"); }
    }
};

template <int MC, int NC> struct StaticOrderZero {
    static constexpr int nM = MC / BM, nN = NC / BM, nwg = nM * nN;
    int G, c;
    __device__ __forceinline__ void init(int G_, int c_) { asm volatile("" : "+s"(G_), "+s"(c_)); G = G_; c = c_; }
    __device__ __forceinline__ bool next(int i, Unit& u) const { const int L = i * G + c; if (L >= nwg) return false; u.pm = 0; u.pn = 0; return true; }
    __device__ __forceinline__ void a_ready(const Unit&) const {}
    __device__ __forceinline__ void done(const Unit&) const {}
};
struct EpiNull {
    static constexpr bool PERM = true, AFTER_DRAIN = false; static constexpr int MID_T = 0;
    float* O;
    typedef PreNone Pre;
    __device__ __forceinline__ Pre prefetch(const Unit&, int, int, int) const { return Pre{}; }
    __device__ __forceinline__ void operator()(const f32x4 (&acc)[2][2][4][2], const Unit& u, int wr, int wc, int fr, int fq, const Pre&) const {
        float s = 0.f;
#pragma unroll
        for (int ai = 0; ai < 2; ++ai)
#pragma unroll
            for (int bj = 0; bj < 2; ++bj)
#pragma unroll
                for (int m = 0; m < 4; ++m)
#pragma unroll
                    for (int n = 0; n < 2; ++n) s += (acc[ai][bj][m][n][0] + acc[ai][bj][m][n][1]) + (acc[ai][bj][m][n][2] + acc[ai][bj][m][n][3]);
        O[(size_t)blockIdx.x * 512 + threadIdx.x] = s + (float)(u.pm + u.pn);
    }
};

template <int MC, int NC> struct StaticOrderC {
    static constexpr int nM = MC / BM, nN = NC / BM, nwg = nM * nN;
    int G, c;
    __device__ __forceinline__ void init(int G_, int c_) { asm volatile("" : "+s"(G_), "+s"(c_)); G = G_; c = c_; }
    __device__ __forceinline__ bool next(int i, Unit& u) const {
        const int L = i * G + c; if (L >= nwg) return false;
        int wgid = L; { constexpr int q = nwg / NXCD, r = nwg % NXCD; const int xcd = wgid % NXCD, off = wgid / NXCD; wgid = (xcd < r ? xcd * (q + 1) : r * (q + 1) + (xcd - r) * q) + off; }
        constexpr int nig = WGM * nN; const int gid = wgid / nig, fm = gid * WGM, gsz = (nM - fm) < WGM ? (nM - fm) : WGM;
        u.pm = fm + ((wgid % nig) % gsz); u.pn = (wgid % nig) / gsz; return true;
    }
    __device__ __forceinline__ void a_ready(const Unit&) const {}
    __device__ __forceinline__ void done(const Unit&) const {}
};

template <class Epi, class Sched, bool ALIGN_EPI, bool SP2, int KC, int LDAC, bool AIMG = false>
__device__ __forceinline__ void gemm_phase(PG8_LAS unsigned char* lds, const Gemm g, const Sched& S, const Epi& E) {
    int tid_ = threadIdx.x; asm volatile("" : "+v"(tid_));
    const int tid = tid_, wid = __builtin_amdgcn_readfirstlane(tid >> 6), lane = tid & 63, wr = wid >> 2, wc = wid & 3, fr = lane & 15, fq = lane >> 4;
    constexpr int K = KC, nt = K / BK; static_assert(KC % 128 == 0 && KC >= 256, "K multiple of 128, >= 256");
    unsigned voffA[2], voffB[2];
#pragma unroll
    for (int i = 0; i < 2; ++i) { int R, C; stage_rc(tid * 16 + i * 8192, R, C); const int Rb = Epi::PERM ? ((R & ~31) + perm32(R & 31)) : R;
        voffA[i] = AIMG ? (unsigned)(tid * 16 + i * 8192) : (unsigned)(R * LDAC + C) * 2u; voffB[i] = (unsigned)(tid * 16 + i * 8192); (void)Rb; }
    constexpr size_t kstep = AIMG ? (size_t)16384 : (size_t)(BK * 2);
    constexpr size_t kstepB = 16384;
    constexpr size_t hstepA = AIMG ? (size_t)HALF * K * 2 : (size_t)HALF * LDAC * 2, hstepB = (size_t)HALF * K * 2;
    constexpr size_t tstepA = 2 * hstepA, tstepB = 2 * hstepB;
    const unsigned ldsw = (unsigned)wid * 1024u;
    const int aoff = lds_byte(wr * 64 + fr, fq * 8), boff = lds_byte(wc * 32 + fr, fq * 8);
#define PG8_SA(b, h) (((b) * 2 + (h)) * HTB)
#define PG8_SB(b, h) ((4 + (b) * 2 + (h)) * HTB)
#define PG8_STAGE(bufoff, gbase, voff) do { _Pragma("unroll") for (int _i = 0; _i < 2; ++_i) \
        __builtin_amdgcn_global_load_lds((const unsigned*)((const char*)(gbase) + (voff)[_i]), (PG8_LAS unsigned*)(lds + (bufoff) + ldsw + _i * 8192), 16, 0, 0); } while (0)
#define PG8_LDA(dst, b, h) do { _Pragma("unroll") for (int m = 0; m < 4; ++m) _Pragma("unroll") for (int k = 0; k < 2; ++k) dst[m][k] = *(const PG8_LAS bf16x8*)(lds + PG8_SA(b, h) + aoff + m * 2048 + k * 1024); } while (0)
#define PG8_LDB(dst, b, h) do { _Pragma("unroll") for (int n = 0; n < 2; ++n) _Pragma("unroll") for (int k = 0; k < 2; ++k) dst[n][k] = *(const PG8_LAS bf16x8*)(lds + PG8_SB(b, h) + boff + n * 2048 + k * 1024); } while (0)
#define PG8_MMA(ai, bj, At, Bt) do { __builtin_amdgcn_s_setprio(1); _Pragma("unroll") for (int m = 0; m < 4; ++m) _Pragma("unroll") for (int n = 0; n < 2; ++n) _Pragma("unroll") for (int k = 0; k < 2; ++k) \
        acc[ai][bj][m][n] = __builtin_amdgcn_mfma_f32_16x16x32_bf16(Bt[n][k], At[m][k], acc[ai][bj][m][n], 0, 0, 0); __builtin_amdgcn_s_setprio(0); } while (0)
#define PG8_WAIT_V(n) asm volatile("s_waitcnt vmcnt(" #n ")" ::: "memory")
#define PG8_WAIT_L(n) asm volatile("s_waitcnt lgkmcnt(" #n ")" ::: "memory")
#define PG8_BAR __builtin_amdgcn_s_barrier()
#define PG8_SCHED __builtin_amdgcn_sched_barrier(0)
    Unit cur, nxt; int ui = 0;
#if defined(GEMM_STAGGER_US)
    if (Sched::nN > 4 && ((blockIdx.x >> 3) & 1)) { const unsigned long long t0_ = __builtin_amdgcn_s_memrealtime(); while (__builtin_amdgcn_s_memrealtime() - t0_ < (unsigned long long)(GEMM_STAGGER_US * 100)) __builtin_amdgcn_s_sleep(8); }
#endif
    if (!S.next(0, cur)) return;
    f32x4 acc[2][2][4][2];
#pragma unroll
    for (int a = 0; a < 2; ++a)
#pragma unroll
        for (int b = 0; b < 2; ++b)
#pragma unroll
            for (int m = 0; m < 4; ++m)
#pragma unroll
                for (int n = 0; n < 2; ++n) acc[a][b][m][n] = (f32x4){0.f, 0.f, 0.f, 0.f};
    bf16x8 At[4][2], B0[2][2], B1[2][2];
    const char* cA = (const char*)g.A + (size_t)cur.pm * tstepA; const char* cB = (const char*)g.Bt + (size_t)cur.pn * tstepB;
    S.a_ready(cur);
    if constexpr (SP2) {
        PG8_STAGE(PG8_SB(0, 0), cB, voffB); PG8_STAGE(PG8_SB(0, 1), cB + hstepB, voffB); PG8_STAGE(PG8_SA(0, 0), cA, voffA); PG8_STAGE(PG8_SA(0, 1), cA + hstepA, voffA);
        if (wr == 1) PG8_BAR;
        PG8_WAIT_V(2); PG8_BAR;
        PG8_STAGE(PG8_SB(1, 0), cB + kstepB, voffB); PG8_STAGE(PG8_SA(1, 0), cA + kstep, voffA); PG8_STAGE(PG8_SB(1, 1), cB + hstepB + kstepB, voffB);
        PG8_WAIT_V(6); PG8_BAR;
    } else {
        PG8_STAGE(PG8_SB(0, 0), cB, voffB); PG8_STAGE(PG8_SA(0, 0), cA, voffA); PG8_STAGE(PG8_SB(0, 1), cB + hstepB, voffB); PG8_STAGE(PG8_SA(0, 1), cA + hstepA, voffA);
        if (wr == 1) PG8_BAR;
        PG8_WAIT_V(4); PG8_BAR;
        PG8_STAGE(PG8_SB(1, 0), cB + kstepB, voffB); PG8_STAGE(PG8_SA(1, 0), cA + kstep, voffA); PG8_STAGE(PG8_SB(1, 1), cB + hstepB + kstepB, voffB);
        PG8_WAIT_V(6); PG8_BAR;
    }
    for (;;) {
        const bool has_next = S.next(ui + 1, nxt);
        const typename Epi::Pre pre = E.prefetch(cur, wr, fr, fq);
        const char* nA = has_next ? (const char*)g.A + (size_t)nxt.pm * tstepA : cA; const char* nB = has_next ? (const char*)g.Bt + (size_t)nxt.pn * tstepB : cB;
        for (int t = 0; t < nt; t += 2) {
            const bool last = (t == nt - 2);
            if constexpr (Epi::MID_T > 0) { if (t == Epi::MID_T) E.mid(acc, cur, wr, wc, fr, fq); }
            const char* a1 = cA + (size_t)(t + 1) * kstep;
            const char* a2 = last ? nA : cA + (size_t)(t + 2) * kstep; const char* b2 = last ? nB : cB + (size_t)(t + 2) * kstepB;
            const char* a3 = a2 + kstep; const char* b3 = b2 + kstepB;
            if (last && has_next) S.a_ready(nxt);
            if constexpr (SP2) {
            PG8_LDB(B0, 0, 0); PG8_LDB(B1, 0, 1); PG8_SCHED; PG8_LDA(At, 0, 0); PG8_STAGE(PG8_SA(1, 1), a1 + hstepA, voffA);
            PG8_WAIT_V(8); PG8_WAIT_L(0); PG8_BAR; PG8_MMA(0, 0, At, B0); PG8_MMA(0, 1, At, B1); PG8_BAR; PG8_SCHED;
            PG8_LDA(At, 0, 1); PG8_STAGE(PG8_SB(0, 0), b2, voffB); PG8_STAGE(PG8_SB(0, 1), b2 + hstepB, voffB); PG8_STAGE(PG8_SA(0, 0), a2, voffA);
            PG8_WAIT_V(8); PG8_WAIT_L(0); PG8_BAR; PG8_MMA(1, 0, At, B0); PG8_MMA(1, 1, At, B1); PG8_BAR; PG8_SCHED;
            PG8_LDB(B0, 1, 0); PG8_LDB(B1, 1, 1); PG8_SCHED; PG8_LDA(At, 1, 0); PG8_STAGE(PG8_SA(0, 1), a2 + hstepA, voffA);
            PG8_WAIT_V(8); PG8_WAIT_L(0); PG8_BAR; PG8_MMA(0, 0, At, B0); PG8_MMA(0, 1, At, B1); PG8_BAR; PG8_SCHED;
            PG8_LDA(At, 1, 1); PG8_STAGE(PG8_SB(1, 0), b3, voffB); PG8_STAGE(PG8_SB(1, 1), b3 + hstepB, voffB); PG8_STAGE(PG8_SA(1, 0), a3, voffA);
            PG8_WAIT_V(8); PG8_WAIT_L(0); PG8_BAR; PG8_MMA(1, 0, At, B0); PG8_MMA(1, 1, At, B1); PG8_BAR; PG8_SCHED;
            } else {
            PG8_LDB(B0, 0, 0); PG8_SCHED; PG8_LDA(At, 0, 0); PG8_STAGE(PG8_SA(1, 1), a1 + hstepA, voffA);
            PG8_WAIT_L(8); PG8_BAR; PG8_WAIT_L(0); PG8_MMA(0, 0, At, B0); PG8_BAR; PG8_SCHED;
            PG8_LDB(B1, 0, 1); PG8_STAGE(PG8_SB(0, 0), b2, voffB);
            PG8_BAR; PG8_WAIT_L(0); PG8_MMA(0, 1, At, B1); PG8_BAR;
            PG8_LDA(At, 0, 1); PG8_STAGE(PG8_SA(0, 0), a2, voffA);
            PG8_BAR; PG8_WAIT_L(0); PG8_MMA(1, 0, At, B0); PG8_BAR; PG8_SCHED;
            PG8_STAGE(PG8_SB(0, 1), b2 + hstepB, voffB);
            PG8_WAIT_V(6); PG8_BAR; PG8_MMA(1, 1, At, B1); PG8_BAR;
            PG8_LDB(B0, 1, 0); PG8_SCHED; PG8_LDA(At, 1, 0); PG8_STAGE(PG8_SA(0, 1), a2 + hstepA, voffA);
            PG8_WAIT_L(8); PG8_BAR; PG8_WAIT_L(0); PG8_MMA(0, 0, At, B0); PG8_BAR; PG8_SCHED;
            PG8_LDB(B1, 1, 1); PG8_STAGE(PG8_SB(1, 0), b3, voffB);
            PG8_BAR; PG8_WAIT_L(0); PG8_MMA(0, 1, At, B1); PG8_BAR;
            PG8_LDA(At, 1, 1); PG8_STAGE(PG8_SA(1, 0), a3, voffA);
            PG8_BAR; PG8_WAIT_L(0); PG8_MMA(1, 0, At, B0); PG8_BAR; PG8_SCHED;
            PG8_STAGE(PG8_SB(1, 1), b3 + hstepB, voffB);
            PG8_WAIT_V(6); PG8_BAR; PG8_MMA(1, 1, At, B1); PG8_BAR;
            }
        }
        if constexpr (ALIGN_EPI) { if (wr == 0) PG8_BAR; }
        if constexpr (!Epi::AFTER_DRAIN) { E(acc, cur, wr, wc, fr, fq, pre); S.done(cur); }
        if (!has_next) break;
#pragma unroll
        for (int a = 0; a < 2; ++a)
#pragma unroll
            for (int b = 0; b < 2; ++b)
#pragma unroll
                for (int m = 0; m < 4; ++m)
#pragma unroll
                    for (int n = 0; n < 2; ++n) acc[a][b][m][n] = (f32x4){0.f, 0.f, 0.f, 0.f};
        cur = nxt; cA = nA; cB = nB; ++ui;
        if constexpr (ALIGN_EPI) { if (wr == 1) PG8_BAR; }
    }
    PG8_WAIT_V(0);
    if constexpr (!ALIGN_EPI) { if (wr == 0) PG8_BAR; }
    PG8_BAR;
    if constexpr (Epi::AFTER_DRAIN) { E.fused(acc, cur, wr, wc, fr, fq, lds, wid, lane); S.done(cur); }
#undef PG8_SA
#undef PG8_SB
#undef PG8_STAGE
#undef PG8_LDA
#undef PG8_LDB
#undef PG8_MMA
#undef PG8_WAIT_V
#undef PG8_WAIT_L
#undef PG8_BAR
#undef PG8_SCHED
}
}
#define GAS __attribute__((address_space(1)))
#define LAS __attribute__((address_space(3)))
typedef unsigned short bf16;
typedef unsigned v4u __attribute__((ext_vector_type(4)));
typedef float f32x4 __attribute__((ext_vector_type(4)));
typedef short bf16x8 __attribute__((ext_vector_type(8)));
typedef GAS unsigned gu32;
typedef GAS unsigned long long gu64;
#define RLX_AGENT __ATOMIC_RELAXED, __HIP_MEMORY_SCOPE_AGENT
#define LDS_WAIT() asm volatile("s_waitcnt lgkmcnt(0)" ::: "memory")
#define VM_WAIT() asm volatile("s_waitcnt vmcnt(0)" ::: "memory")
__device__ __forceinline__ unsigned long long rt() { return __builtin_amdgcn_s_memrealtime(); }
__device__ __forceinline__ unsigned f2bf(float f) { unsigned u = __builtin_bit_cast(unsigned, f); return (u + 0x7fffu + ((u >> 16) & 1u)) >> 16; }
__device__ __forceinline__ unsigned pk2(float lo, float hi) { return f2bf(lo) | (f2bf(hi) << 16); }
#define XB_TMO      128
#define XB_XCNT(j)  (256  + 64 * (j))
#define XB_XSUB(j)  (1280 + 64 * (j))
#define XB_XGEN(j)  (2304 + 64 * (j))
#define XB_TOP      3328
#define XB_TOPGEN   3392
#define XCD_BAR_WORDS 3456
#define XB_SPIN_CAP (1u << 18)

__device__ __forceinline__ unsigned xb_ld(unsigned* p)              { return __hip_atomic_load(p, __ATOMIC_RELAXED, __HIP_MEMORY_SCOPE_AGENT); }
__device__ __forceinline__ unsigned xb_add(unsigned* p, unsigned v) { return __hip_atomic_fetch_add(p, v, __ATOMIC_RELAXED, __HIP_MEMORY_SCOPE_AGENT); }
__device__ __forceinline__ unsigned xb_xcc_id() { return (unsigned)__builtin_amdgcn_s_getreg((3 << 11) | 20) & 0xFu; }
#define XB_SPIN(cond, bar) do { unsigned _sp = 0; while (cond) { __builtin_amdgcn_s_sleep(1); \
    if ((++_sp & 255u) == 0u) { if (xb_ld(&(bar)[XB_TMO])) break; if (_sp > XB_SPIN_CAP) { atomicAdd(&(bar)[XB_TMO], 1u); break; } } } } while (0)

struct XcdBarrier {
    unsigned* bar; unsigned x;
    volatile LAS unsigned* st;
};

__device__ __forceinline__ XcdBarrier xcd_barrier_post(unsigned* bar, volatile LAS unsigned* st) {
    XcdBarrier b; b.bar = bar; b.x = xb_xcc_id(); b.st = st;
    if (threadIdx.x == 0) (void)xb_add(&bar[XB_XCNT(b.x)], 1u);
    return b;
}
__device__ __forceinline__ void xcd_barrier_complete(unsigned* bar, unsigned x, unsigned& nloc, unsigned& nx) {
    const unsigned G = gridDim.x * gridDim.y * gridDim.z;
    unsigned sum, cnt, mine, sp = 0u;
    for (;;) {
        sum = 0u; cnt = 0u; mine = 0u;
        unsigned cv[16];
        { const unsigned char* cb_ = (const unsigned char*)&bar[XB_XCNT(8)];
          asm volatile("global_load_dword %0, %16, off offset:-2048 sc1\n\tglobal_load_dword %1, %16, off offset:-1792 sc1\n\tglobal_load_dword %2, %16, off offset:-1536 sc1\n\tglobal_load_dword %3, %16, off offset:-1280 sc1\n\t"
                       "global_load_dword %4, %16, off offset:-1024 sc1\n\tglobal_load_dword %5, %16, off offset:-768 sc1\n\tglobal_load_dword %6, %16, off offset:-512 sc1\n\tglobal_load_dword %7, %16, off offset:-256 sc1\n\t"
                       "global_load_dword %8, %16, off sc1\n\tglobal_load_dword %9, %16, off offset:256 sc1\n\tglobal_load_dword %10, %16, off offset:512 sc1\n\tglobal_load_dword %11, %16, off offset:768 sc1\n\t"
                       "global_load_dword %12, %16, off offset:1024 sc1\n\tglobal_load_dword %13, %16, off offset:1280 sc1\n\tglobal_load_dword %14, %16, off offset:1536 sc1\n\tglobal_load_dword %15, %16, off offset:1792 sc1\n\ts_waitcnt vmcnt(0)"
                       : "=&v"(cv[0]), "=&v"(cv[1]), "=&v"(cv[2]), "=&v"(cv[3]), "=&v"(cv[4]), "=&v"(cv[5]), "=&v"(cv[6]), "=&v"(cv[7]), "=&v"(cv[8]), "=&v"(cv[9]), "=&v"(cv[10]), "=&v"(cv[11]), "=&v"(cv[12]), "=&v"(cv[13]), "=&v"(cv[14]), "=&v"(cv[15])
                       : "v"(cb_) : "memory"); }
#pragma unroll
        for (unsigned j = 0; j < 16; ++j) { const unsigned c = cv[j]; sum += c; cnt += (c > 0u) ? 1u : 0u; mine = (j == x) ? c : mine; }
        if (sum == G) break;
        __builtin_amdgcn_s_sleep(1);
        if ((++sp & 255u) == 0u) { if (xb_ld(&bar[XB_TMO])) break; if (sp > XB_SPIN_CAP) { atomicAdd(&bar[XB_TMO], 1u); break; } }
    }
    nloc = mine > 0u ? mine : 1u; nx = cnt > 0u ? cnt : 1u;
}

__device__ __forceinline__ void xcd_barrier(const XcdBarrier& b) {
    asm volatile("s_waitcnt vmcnt(0)" ::: "memory");
    __syncthreads();
    if (threadIdx.x == 0) {
        unsigned* bar = b.bar;
        __builtin_amdgcn_s_waitcnt(0);
        unsigned nloc = b.st[0], nx = b.st[1];
        if (nloc == 0u) { xcd_barrier_complete(bar, b.x, nloc, nx); b.st[0] = nloc; b.st[1] = nx; }
        const unsigned old = xb_add(&bar[XB_XSUB(b.x)], 1u);
        const unsigned gen = old / nloc;
        if (old + 1u == (gen + 1u) * nloc) {
            __builtin_amdgcn_fence(__ATOMIC_RELEASE, "agent");
            asm volatile("s_waitcnt vmcnt(0)" ::: "memory");
            const unsigned og = xb_add(&bar[XB_TOP], 1u);
            const unsigned tg = og / nx;
            if (og + 1u == (tg + 1u) * nx) xb_add(&bar[XB_TOPGEN], 1u);
            else XB_SPIN(xb_ld(&bar[XB_TOPGEN]) == tg, bar);
            __builtin_amdgcn_fence(__ATOMIC_ACQUIRE, "agent");
            xb_add(&bar[XB_XGEN(b.x)], 1u);
            asm volatile("s_waitcnt vmcnt(0)" ::: "memory");
        } else {
            XB_SPIN(xb_ld(&bar[XB_XGEN(b.x)]) == gen, bar);
            __builtin_amdgcn_fence(__ATOMIC_ACQUIRE, "agent");
            asm volatile("s_waitcnt vmcnt(0)" ::: "memory");
        }
    }
    __syncthreads();
}

constexpr size_t MiB_ = 1u << 20;
constexpr int NWAVES = 8;
constexpr int BATCH = 8, SEQ = 4096, DM = 1024, MROWS = BATCH * SEQ, DEPTH = 2;
constexpr int DFF = 2816, DIN = 5632;
constexpr int HG_H = 4, HG_D = 128, HG_W = 512;
constexpr int MB_H = 8, MB_D = 64, MB_BS = 256, MB_NB = SEQ / MB_BS;
constexpr int C_HQ = 0, C_HF = 512, C_HI = 1024, C_HG = 1536, C_MQ = 2048, C_MK = 2560, C_MV = 3072, C_GA = 3584, C_GB = 4608;
constexpr size_t BIG_HQ = 0, BIG_HF = 32 * MiB_, BIG_HI = 64 * MiB_, BIG_HGT = 96 * MiB_, BIG_Q2 = 128 * MiB_, BIG_GIMG = 160 * MiB_, BIG_OAB = 288 * MiB_;
constexpr int Q2W = 512;
constexpr float NORM_EPS = 1e-6f, MIN_FORGET = 1e-20f, LOG2E = 1.4426950408889634f;

constexpr size_t MiB = 1u << 20;
constexpr size_t WS_CTL = 0, CTL_ZERO_BYTES = 3 * MiB;
constexpr size_t WS_SS = 1 * MiB;
constexpr size_t WS_LB = 5 * MiB;
constexpr size_t WS_KMEAN = 5 * MiB + 65536;
constexpr size_t WS_W = 8 * MiB;
constexpr size_t W_GU1 = 0, W_DN1 = 11 * MiB, W_IN = W_DN1 + 11 * MiB / 2, W_A = W_IN + 11 * MiB, W_B = W_A + 1 * MiB, W_OUT = W_B + 1 * MiB, W_GU2 = W_OUT + 2 * MiB, W_DN2 = W_GU2 + 11 * MiB, W_END = W_DN2 + 11 * MiB / 2;
static_assert(W_END == 48 * MiB, "weight map");
constexpr size_t WS_H = 56 * MiB;
constexpr size_t WS_BIG = 120 * MiB;
constexpr size_t WS_END = WS_BIG + (size_t)MROWS * DIN * 2;
static_assert(WS_END == 472 * MiB, "d_ws map");
constexpr int CW_TMO = 0, CW_BAR = 4096;

constexpr int RING_OFF = 0, RING_BYTES = 131072;
constexpr int LDSCTL_OFF = RING_BYTES, MISC_OFF = LDSCTL_OFF + 320;
constexpr int LDS_BYTES = 147456;
static_assert(MISC_OFF + 128 <= LDS_BYTES, "LDS map");

struct Frame {
    LAS unsigned char* lds;
    volatile LAS unsigned* MISC;
    gu32* ctl;
    int tid, lane, wave, G;
    unsigned char* ws;
    float* xo;
};

#define PHASE_IDS(F) int tid_ = threadIdx.x; asm volatile("" : "+v"(tid_)); const int tid = tid_, lane = tid & 63, wave = __builtin_amdgcn_readfirstlane(tid >> 6); \
    int bid_ = blockIdx.x, G_ = gridDim.x; asm volatile("" : "+s"(bid_), "+s"(G_)); const int bid = bid_, G = G_; \
    unsigned zoff_ = 0u; asm volatile("" : "+s"(zoff_)); unsigned char* ws = (F).ws + zoff_;     LAS unsigned char* ldsb = (F).lds; (void)tid; (void)lane; (void)wave; (void)bid; (void)G; (void)ws; (void)ldsb;
__device__ __forceinline__ float wave_sum(float v) {
#pragma unroll
    for (int o = 1; o < 64; o <<= 1) v += __shfl_xor(v, o);
    return v;
}
__device__ __forceinline__ float wave_max(float v) {
#pragma unroll
    for (int o = 1; o < 64; o <<= 1) v = fmaxf(v, __shfl_xor(v, o));
    return v;
}
__device__ __forceinline__ float bflo(unsigned u) { return __uint_as_float(u << 16); }
__device__ __forceinline__ float bfhi(unsigned u) { return __uint_as_float(u & 0xffff0000u); }
__device__ __forceinline__ float bf1(bf16 u) { return __uint_as_float((unsigned)u << 16); }
__device__ __forceinline__ float sigmoid_f(float x) { return __builtin_amdgcn_rcpf(1.0f + __builtin_amdgcn_exp2f(x * -1.4426950408889634f)); }

template <bool GU>
__device__ __forceinline__ void cvt_block(const float* W, int K, int N, bf16* WT, LAS float* scr, int item, int tid, const float* gain = nullptr, int Kdst = 0, int koff = 0) {
    const int nblk = N / 128, kb = item / nblk, nb = item % nblk, k0 = 64 * kb, n0 = 128 * nb;
    f32x4 v[4]; float gk[4];
#pragma unroll
    for (int i = 0; i < 4; ++i) { const int idx = tid + 512 * i, kk = idx >> 5, n4 = (idx & 31) * 4;
        gk[i] = gain ? gain[k0 + kk] : 1.0f; v[i] = *(const f32x4*)(W + (size_t)(k0 + kk) * N + n0 + n4); }
#pragma unroll
    for (int i = 0; i < 4; ++i) asm volatile("" : "+v"(v[i]), "+v"(gk[i]));
#pragma unroll
    for (int i = 0; i < 4; ++i) { const int idx = tid + 512 * i, kk = idx >> 5, n4 = (idx & 31) * 4;
        LAS float* s = scr + kk * 129 + n4; s[0] = v[i].x * gk[i]; s[1] = v[i].y * gk[i]; s[2] = v[i].z * gk[i]; s[3] = v[i].w * gk[i]; }
    __syncthreads();
    int half = n0 >> 7;
    if (GU) { const int j = (n0 >= DFF) ? n0 - DFF : n0; half = 2 * (j >> 7) + ((n0 >= DFF) ? 1 : 0); }
    const int Kd = Kdst ? Kdst : K; const int kk0 = koff + k0;
    GAS unsigned char* blk = (GAS unsigned char*)WT + ((size_t)half * (Kd >> 6) + (kk0 >> 6)) * 16384;
#pragma unroll
    for (int j = 0; j < 2; ++j) { const int p = tid + 512 * j, R = p >> 3, c = p & 7;
        const int rn = (R & ~31) + pg8::perm32(R & 31); const LAS float* s = scr + (8 * c) * 129 + rn;
        v4u o; o.x = pk2(s[0 * 129], s[1 * 129]); o.y = pk2(s[2 * 129], s[3 * 129]); o.z = pk2(s[4 * 129], s[5 * 129]); o.w = pk2(s[6 * 129], s[7 * 129]);
        *(GAS v4u*)(blk + pg8::lds_byte(R, 8 * c)) = o; }
    __syncthreads();
}
__device__ __forceinline__ void phase_convert(Frame& F, const float* const* in, int l) {
    PHASE_IDS(F);
    LAS float* scr = (LAS float*)(ldsb + RING_OFF);
    constexpr int I_GU = (DM / 64) * (2 * DFF / 128), I_DN = (DFF / 64) * (DM / 128), I_IN = (DM / 64) * (DIN / 128), I_A = (512 / 64) * (DM / 128), I_O = (DM / 64) * (DM / 128);
    constexpr int NITEMS = 2 * I_GU + 2 * I_DN + I_IN + 2 * I_A + I_O;
    unsigned char* wb = ws + WS_W;
    for (int it = bid; it < NITEMS; it += G) {
        int r = it;
        if (r < I_GU) { cvt_block<true>(in[2] + (size_t)l * DM * 2 * DFF, DM, 2 * DFF, (bf16*)(wb + W_GU1), scr, r, tid, in[1] + l * DM); continue; } r -= I_GU;
        if (r < I_GU) { cvt_block<true>(in[12] + (size_t)l * DM * 2 * DFF, DM, 2 * DFF, (bf16*)(wb + W_GU2), scr, r, tid, in[11] + l * DM); continue; } r -= I_GU;
        if (r < I_IN) { cvt_block<false>(in[5] + (size_t)l * DM * DIN, DM, DIN, (bf16*)(wb + W_IN), scr, r, tid, in[4] + l * DM); continue; } r -= I_IN;
        if (r < I_DN) { cvt_block<false>(in[3] + (size_t)l * DFF * DM, DFF, DM, (bf16*)(wb + W_DN1), scr, r, tid); continue; } r -= I_DN;
        if (r < I_DN) { cvt_block<false>(in[13] + (size_t)l * DFF * DM, DFF, DM, (bf16*)(wb + W_DN2), scr, r, tid); continue; } r -= I_DN;
        if (r < I_A) { cvt_block<false>(in[8] + (size_t)l * 512 * DM, 512, DM, (bf16*)(wb + W_A), scr, r, tid, nullptr, 1024, 0); continue; } r -= I_A;
        if (r < I_A) { cvt_block<false>(in[9] + (size_t)l * 512 * DM, 512, DM, (bf16*)(wb + W_A), scr, r, tid, nullptr, 1024, 512); continue; } r -= I_A;
        cvt_block<false>(in[10] + (size_t)l * DM * DM, DM, DM, (bf16*)(wb + W_OUT), scr, r, tid);
    }
}
__device__ __forceinline__ void phase_rmsnorm_bf16(Frame& F, const float* x, const float* gain, bf16* out) {
    PHASE_IDS(F);
    const int gw = bid * NWAVES + wave, NGW = G * NWAVES;
    f32x4 g[4];
#pragma unroll
    for (int j = 0; j < 4; ++j) g[j] = ((const f32x4*)gain)[64 * j + lane];
    for (int m = gw; m < MROWS; m += NGW) {
        const f32x4* xr = (const f32x4*)(x + (size_t)m * DM) + lane;
        f32x4 v[4]; float s = 0.f;
#pragma unroll
        for (int j = 0; j < 4; ++j) { v[j] = xr[64 * j]; s += (v[j].x * v[j].x + v[j].y * v[j].y) + (v[j].z * v[j].z + v[j].w * v[j].w); }
        const float r = 1.0f / sqrtf(wave_sum(s) * (1.0f / DM) + NORM_EPS);
        unsigned long long* o8 = (unsigned long long*)(out + (size_t)m * DM) + lane;
#pragma unroll
        for (int j = 0; j < 4; ++j) o8[64 * j] = (unsigned long long)pk2(v[j].x * r * g[j].x, v[j].y * r * g[j].y) | ((unsigned long long)pk2(v[j].z * r * g[j].z, v[j].w * r * g[j].w) << 32);
    }
}
__device__ __forceinline__ void phase_rmsnorm_f32(Frame& F, float* x, const float* gain) {
    PHASE_IDS(F);
    const int gw = bid * NWAVES + wave, NGW = G * NWAVES;
    f32x4 g[4];
#pragma unroll
    for (int j = 0; j < 4; ++j) g[j] = ((const f32x4*)gain)[64 * j + lane];
    for (int m = gw; m < MROWS; m += NGW) {
        f32x4* xr = (f32x4*)(x + (size_t)m * DM) + lane;
        f32x4 v[4]; float s = 0.f;
#pragma unroll
        for (int j = 0; j < 4; ++j) { v[j] = xr[64 * j]; s += (v[j].x * v[j].x + v[j].y * v[j].y) + (v[j].z * v[j].z + v[j].w * v[j].w); }
        const float r = 1.0f / sqrtf(wave_sum(s) * (1.0f / DM) + NORM_EPS);
#pragma unroll
        for (int j = 0; j < 4; ++j) xr[64 * j] = v[j] * r * g[j];
    }
}

__device__ __forceinline__ void phase_xb_ss(Frame& F, const float* x, bf16* xb, unsigned long long* ss) {
    PHASE_IDS(F);
    const int gw = bid * NWAVES + wave, NGW = G * NWAVES;
    for (int m = gw; m < MROWS; m += NGW) {
        const f32x4* xr = (const f32x4*)(x + (size_t)m * DM) + lane;
        f32x4 v[4]; float s = 0.f;
#pragma unroll
        for (int j = 0; j < 4; ++j) { v[j] = xr[64 * j]; s += (v[j].x * v[j].x + v[j].y * v[j].y) + (v[j].z * v[j].z + v[j].w * v[j].w); }
        s = wave_sum(s);
#pragma unroll
        for (int j = 0; j < 4; ++j) { const int col = 256 * j + 4 * lane;
            *(unsigned long long*)((unsigned char*)xb + pg8::img_off(m, col & ~7, DM) + (col & 4) * 2) = (unsigned long long)pk2(v[j].x, v[j].y) | ((unsigned long long)pk2(v[j].z, v[j].w) << 32); }
        if (lane == 0) ss[m] = (unsigned long long)(s * 16777216.0f);
    }
}
__device__ __forceinline__ void phase_final_norm(Frame& F, const bf16* xb, float* out, const float* gain, const unsigned long long* ss) {
    PHASE_IDS(F);
    const int gw = bid * NWAVES + wave, NGW = G * NWAVES;
    f32x4 g[4];
#pragma unroll
    for (int j = 0; j < 4; ++j) g[j] = ((const f32x4*)gain)[64 * j + lane];
    for (int m = gw; m < MROWS; m += NGW) {
        f32x4* orow = (f32x4*)(out + (size_t)m * DM) + lane;
        const float r = 1.0f / sqrtf((float)ss[m] * (1.0f / 16777216.0f) * (1.0f / DM) + NORM_EPS);
#pragma unroll
        for (int j = 0; j < 4; ++j) { const int col = 256 * j + 4 * lane; const unsigned long long v = *(const unsigned long long*)((const unsigned char*)xb + pg8::img_off(m, col & ~7, DM) + (col & 4) * 2); const unsigned lo = (unsigned)v, hi = (unsigned)(v >> 32);
            f32x4 ov_ = (f32x4){bflo(lo), bfhi(lo), bflo(hi), bfhi(hi)} * r * g[j];
#if defined(PROBE_TS)
            ov_ = ov_ + 0.01f * sqrtf(((const float*)(ws + WS_LB))[4000]);
#endif
            orow[64 * j] = ov_; }
    }
}
__device__ __forceinline__ void compute_lb(Frame& F, const float* logits) {
    PHASE_IDS(F);
    float* lb = (float*)(ws + WS_LB);
    if (bid == 0) {
        const int d = tid;
        float mx = -INFINITY;
        for (int l = 0; l < DEPTH; ++l) mx = fmaxf(mx, logits[l * 512 + d]);
        float den = 0.f;
        for (int l = 0; l < DEPTH; ++l) den += expf(logits[l * 512 + d] - mx);
        const float sm0 = expf(logits[d] - mx) / den;
        float cum = 0.f;
        for (int l = 0; l < DEPTH; ++l) { cum += expf(logits[l * 512 + d] - mx) / den; lb[l * 512 + d] = fminf(fmaxf(cum - sm0, 0.f), 1.f); }
    }
}
constexpr size_t KIMG_OFF = 64 * MiB, VIMG_OFF = 96 * MiB;
__device__ __forceinline__ void phase_kmean(Frame& F) {
    PHASE_IDS(F);
    const unsigned char* kimg = (const unsigned char*)F.xo + KIMG_OFF + zoff_;
    float* kmean = (float*)(ws + WS_KMEAN);
    v4u kc[4] = {}, kn[4] = {};
#define KM_LOAD(dst, T) do { _Pragma("unroll") for (int t = 0; t < 4; ++t) dst[t] = *(const v4u*)(kimg + ((size_t)((T) >> 4) * (SEQ / 64) + ((T) & 15) * 4 + t) * 8192 + wave * 1024 + lane * 16); } while (0)
    if (bid < BATCH * MB_H * MB_NB) KM_LOAD(kc, bid);
    for (int tsk = bid; tsk < BATCH * MB_H * MB_NB; tsk += G) {
        const int bh = tsk >> 4, n = tsk & 15;
        if (tsk + G < BATCH * MB_H * MB_NB) KM_LOAD(kn, tsk + G);
#pragma unroll
        for (int t = 0; t < 4; ++t) asm volatile("" : "+v"(kc[t]));
        float a[8];
#pragma unroll
        for (int j = 0; j < 8; ++j) a[j] = 0.f;
#pragma unroll
        for (int t = 0; t < 4; ++t) { const v4u kv = kc[t];
            a[0] += bflo(kv.x); a[1] += bfhi(kv.x); a[2] += bflo(kv.y); a[3] += bfhi(kv.y); a[4] += bflo(kv.z); a[5] += bfhi(kv.z); a[6] += bflo(kv.w); a[7] += bfhi(kv.w); }
#pragma unroll
        for (int j = 0; j < 8; ++j) a[j] = wave_sum(a[j]);
        if (lane < 8) { float v = a[0];
#pragma unroll
            for (int j = 1; j < 8; ++j) v = (lane == j) ? a[j] : v;
            kmean[((size_t)bh * MB_NB + n) * MB_D + wave * 8 + lane] = v * (1.0f / MB_BS); }
#pragma unroll
        for (int t = 0; t < 4; ++t) kc[t] = kn[t];
    }
#undef KM_LOAD
}

constexpr size_t WS_DC = 6 * MiB;
constexpr int HG_UNITS = BATCH * HG_H * (SEQ / 64);
constexpr int HP_TD = 272, HP_VS = 144;
typedef float f32x4v __attribute__((ext_vector_type(4)));
__device__ __forceinline__ f32x4v mfma16(bf16x8 a, bf16x8 b, f32x4v c) { return __builtin_amdgcn_mfma_f32_16x16x32_bf16(a, b, c, 0, 0, 0); }
typedef float f32x2_t __attribute__((ext_vector_type(2))); typedef __bf16 bf16x2_t __attribute__((ext_vector_type(2)));
__device__ __forceinline__ unsigned pkbf(float lo, float hi) { const f32x2_t v = {lo, hi}; const bf16x2_t b = __builtin_convertvector(v, bf16x2_t); return __builtin_bit_cast(unsigned, b); }

#define HG_PIN(a) do { _Pragma("unroll") for (int p_ = 0; p_ < 16; ++p_) asm volatile("" : "+v"((a)[p_])); } while (0)
#define HG_BAR() do { asm volatile("s_waitcnt lgkmcnt(0)" ::: "memory"); __builtin_amdgcn_s_barrier(); asm volatile("" ::: "memory"); } while (0)
__device__ __forceinline__ void phase_hgrn_A(Frame& F, int l) {
    PHASE_IDS(F);
    const bf16* HF = (const bf16*)(ws + WS_BIG + BIG_HF); const bf16* HI = (const bf16*)(ws + WS_BIG + BIG_HI);
    const float* lbp = (const float*)(ws + WS_LB) + l * 512;
    bf16* ST = (bf16*)((unsigned char*)F.xo + zoff_);
    float* DC = (float*)(ws + WS_DC);
    LAS unsigned char* KT = ldsb; LAS unsigned char* IT = ldsb + 18432; LAS float* TOT = (LAS float*)(ldsb + 36864);
    const int d = tid & 127, sc = tid >> 7;
    unsigned rf[16], ri[16]; float lbn = 0.f;
#define HGA_LOAD(U) do { const int bh_ = (U) >> 6, c_ = (U) & 63; const size_t r0_ = (size_t)(bh_ >> 2) * SEQ + c_ * 64 + sc * 16; \
        const size_t e0_ = ((size_t)bh_ * SEQ + c_ * 64 + sc * 16) * HG_D + d; (void)r0_; const bf16* pf_ = HF + e0_; const bf16* pi_ = HI + e0_;     \
        lbn = lbp[(bh_ & 3) * HG_D + d];     \
        _Pragma("unroll") for (int tt = 0; tt < 16; ++tt) rf[tt] = pf_[(size_t)tt * HG_D]; \
        _Pragma("unroll") for (int tt = 0; tt < 16; ++tt) ri[tt] = pi_[(size_t)tt * HG_D]; } while (0)
    if (bid < HG_UNITS) HGA_LOAD(bid);
    unsigned long long stdef[8]; bf16* stp = nullptr;
#define HGA_FLUSH() do { if (stp) { _Pragma("unroll") for (int a = 0; a < 2; ++a) _Pragma("unroll") for (int v = 0; v < 4; ++v) *(unsigned long long*)(stp + (size_t)(16 * v) * HG_D + 16 * a) = stdef[a * 4 + v]; } } while (0)
    for (int unit = bid; unit < HG_UNITS; unit += G) {
        const int bh = unit >> 6, h = bh & 3; (void)h;
        HG_PIN(rf); HG_PIN(ri); asm volatile("" : "+v"(lbn));
        const float lbv = lbn;
        float bl[16], kf[16]; unsigned ipk[8];
        float run = 0.f;
#pragma unroll
        for (int tt = 0; tt < 16; ++tt) { const float sg = sigmoid_f(__uint_as_float(rf[tt] << 16));
            run += __builtin_amdgcn_logf(fmaxf(lbv + (1.0f - lbv) * sg, MIN_FORGET)); bl[tt] = run; kf[tt] = (1.0f - lbv) * (1.0f - sg); }
#pragma unroll
        for (int k = 0; k < 8; ++k) ipk[k] = ri[2 * k] | (ri[2 * k + 1] << 16);
        TOT[sc * 128 + d] = run;
        *(LAS v4u*)(IT + d * HP_VS + sc * 32) = (v4u){ipk[0], ipk[1], ipk[2], ipk[3]};
        *(LAS v4u*)(IT + d * HP_VS + sc * 32 + 16) = (v4u){ipk[4], ipk[5], ipk[6], ipk[7]};
        HG_BAR();
        HGA_FLUSH();
        if (unit + G < HG_UNITS) HGA_LOAD(unit + G);
        float pre = 0.f, total = 0.f;
#pragma unroll
        for (int s4 = 0; s4 < 4; ++s4) { const float t = TOT[s4 * 128 + d]; total += t; if (s4 < sc) pre += t; }
        unsigned kpk[8];
#pragma unroll
        for (int k = 0; k < 8; ++k) kpk[k] = pkbf(kf[2 * k] * __builtin_amdgcn_exp2f(total - (pre + bl[2 * k])), kf[2 * k + 1] * __builtin_amdgcn_exp2f(total - (pre + bl[2 * k + 1])));
        *(LAS v4u*)(KT + d * HP_VS + sc * 32) = (v4u){kpk[0], kpk[1], kpk[2], kpk[3]};
        *(LAS v4u*)(KT + d * HP_VS + sc * 32 + 16) = (v4u){kpk[4], kpk[5], kpk[6], kpk[7]};
        if (sc == 0) DC[(size_t)unit * HG_D + d] = __builtin_amdgcn_exp2f(total);
        HG_BAR();
        const int dt0 = 2 * (wave & 3), vt0 = 4 * (wave >> 2), lr = lane & 15, lq = lane >> 4;
        f32x4v acc[2][4];
#pragma unroll
        for (int a = 0; a < 2; ++a)
#pragma unroll
            for (int v = 0; v < 4; ++v) acc[a][v] = (f32x4v){0.f, 0.f, 0.f, 0.f};
#pragma unroll
        for (int kb = 0; kb < 2; ++kb) { bf16x8 af[2], bfr[4];
#pragma unroll
            for (int a = 0; a < 2; ++a) af[a] = *(const LAS bf16x8*)(KT + (16 * (dt0 + a) + lr) * HP_VS + kb * 64 + lq * 16);
#pragma unroll
            for (int v = 0; v < 4; ++v) bfr[v] = *(const LAS bf16x8*)(IT + (16 * (vt0 + v) + lr) * HP_VS + kb * 64 + lq * 16);
#pragma unroll
            for (int a = 0; a < 2; ++a)
#pragma unroll
                for (int v = 0; v < 4; ++v) acc[a][v] = mfma16(af[a], bfr[v], acc[a][v]); }
#pragma unroll
        for (int a = 0; a < 2; ++a)
#pragma unroll
            for (int v = 0; v < 4; ++v) stdef[a * 4 + v] = (unsigned long long)pkbf(acc[a][v][0], acc[a][v][1]) | ((unsigned long long)pkbf(acc[a][v][2], acc[a][v][3]) << 32);
        stp = ST + ((size_t)unit * HG_D + 16 * vt0 + lr) * HG_D + 16 * dt0 + 4 * lq;
        HG_BAR();
    }
    HGA_FLUSH();
#undef HGA_FLUSH
}
__device__ __forceinline__ void phase_hgrn_B(Frame& F) {
    PHASE_IDS(F);
    bf16* ST = (bf16*)((unsigned char*)F.xo + zoff_);
    const float* DC = (const float*)(ws + WS_DC);
    for (int e = bid * (NWAVES * 64) + tid; e < BATCH * HG_H * HG_D * (HG_D / 4); e += G * NWAVES * 64) {
        const int bh = e >> 12, rem = e & 4095, v = rem >> 5, dq = (rem & 31) * 4;
        float S0 = 0.f, S1 = 0.f, S2 = 0.f, S3 = 0.f;
        unsigned long long* p = (unsigned long long*)(ST + ((size_t)(bh * 64) * HG_D + v) * HG_D + dq);
        const f32x4* dp = (const f32x4*)(DC + (size_t)(bh * 64) * HG_D + dq);
#pragma unroll 8
        for (int c = 0; c < 64; ++c) {
            const unsigned long long L = p[(size_t)c * (HG_D * HG_D / 4)]; const f32x4 D = dp[(size_t)c * (HG_D / 4)];
            p[(size_t)c * (HG_D * HG_D / 4)] = (unsigned long long)pkbf(S0, S1) | ((unsigned long long)pkbf(S2, S3) << 32);
            const unsigned lo = (unsigned)L, hi = (unsigned)(L >> 32);
            S0 = D.x * S0 + bflo(lo); S1 = D.y * S1 + bfhi(lo); S2 = D.z * S2 + bflo(hi); S3 = D.w * S3 + bfhi(hi);
        }
    }
}
__device__ __forceinline__ void phase_hgrn_C(Frame& F, int l, const float* normw, size_t out_off, int opitch, int ocol) {
    PHASE_IDS(F);
    const bf16* HQ = (const bf16*)(ws + WS_BIG + BIG_HQ); const bf16* HF = (const bf16*)(ws + WS_BIG + BIG_HF); const bf16* HI = (const bf16*)(ws + WS_BIG + BIG_HI); const bf16* HGT = (const bf16*)(ws + WS_BIG + BIG_HGT);
    const float* lbp = (const float*)(ws + WS_LB) + l * 512;
    const bf16* ST = (const bf16*)((unsigned char*)F.xo + zoff_);
    LAS unsigned char* QH = ldsb; LAS unsigned char* QT = ldsb + 17408; LAS unsigned char* KTI = ldsb + 34816; LAS unsigned char* IT = ldsb + 78336; LAS unsigned char* AT = ldsb + 96768;
    LAS float* TOT = (LAS float*)(ldsb + 105984); LAS float* FIRST = (LAS float*)(ldsb + 108032); LAS float* SSQ = (LAS float*)(ldsb + 110080);
    const int d = tid & 127, sc = tid >> 7, lr = lane & 15, lq = lane >> 4;
    unsigned rf[16], rq[16], ri[16]; float lbn = 0.f;
#define HGC_LOAD(U) do { const int bh_ = (U) >> 6, c_ = (U) & 63; const size_t r0_ = (size_t)(bh_ >> 2) * SEQ + c_ * 64 + sc * 16; \
        const size_t e0_ = ((size_t)bh_ * SEQ + c_ * 64 + sc * 16) * HG_D + d; (void)r0_; const bf16* pq_ = HQ + e0_; const bf16* pf_ = HF + e0_; const bf16* pi_ = HI + e0_; \
        lbn = lbp[(bh_ & 3) * HG_D + d]; \
        _Pragma("unroll") for (int tt = 0; tt < 16; ++tt) rf[tt] = pf_[(size_t)tt * HG_D]; \
        _Pragma("unroll") for (int tt = 0; tt < 16; ++tt) rq[tt] = pq_[(size_t)tt * HG_D]; \
        _Pragma("unroll") for (int tt = 0; tt < 16; ++tt) ri[tt] = pi_[(size_t)tt * HG_D]; } while (0)
    if (bid < HG_UNITS) HGC_LOAD(bid);
    unsigned long long ydef[4]; bf16* yp = nullptr;
#define HGC_FLUSH() do { if (yp) { _Pragma("unroll") for (int tt = 0; tt < 4; ++tt) *(unsigned long long*)(yp + (size_t)(16 * tt) * opitch) = ydef[tt]; } } while (0)
#if defined(PROBE_HT)
    unsigned long long ht_acc[6] = {0, 0, 0, 0, 0, 0}, ht_prev = __builtin_amdgcn_s_memrealtime();
#define HT_MARK(k) do { const unsigned long long n_ = __builtin_amdgcn_s_memrealtime(); ht_acc[k] += n_ - ht_prev; ht_prev = n_; } while (0)
#else
#define HT_MARK(k) do {} while (0)
#endif
    for (int unit = bid; unit < HG_UNITS; unit += G) {
        const int bh = unit >> 6, c = unit & 63, b = bh >> 2, h = bh & 3;
        const size_t rowu = (size_t)b * SEQ + c * 64;
        bf16x8 sf[4];
#pragma unroll
        for (int kb = 0; kb < 4; ++kb) sf[kb] = *(const bf16x8*)(ST + ((size_t)unit * HG_D + 16 * wave + lr) * HG_D + kb * 32 + lq * 8);
        unsigned long long gq[4];
#pragma unroll
        for (int tt = 0; tt < 4; ++tt) gq[tt] = *(const unsigned long long*)(HGT + ((size_t)bh * SEQ + c * 64 + 16 * tt + lr) * HG_D + 16 * wave + 4 * lq);
        {
            HG_PIN(rf); HG_PIN(rq); HG_PIN(ri); asm volatile("" : "+v"(lbn));
            const float lbv = lbn;
            float bl[16], kf[16], qf[16]; unsigned ipk[8];
            float run = 0.f;
#pragma unroll
            for (int tt = 0; tt < 16; ++tt) { const float sg = sigmoid_f(__uint_as_float(rf[tt] << 16));
                run += __builtin_amdgcn_logf(fmaxf(lbv + (1.0f - lbv) * sg, MIN_FORGET)); bl[tt] = run; kf[tt] = (1.0f - lbv) * (1.0f - sg);
                const float q = __uint_as_float(rq[tt] << 16); qf[tt] = q * sigmoid_f(q); }
#pragma unroll
            for (int k = 0; k < 8; ++k) ipk[k] = ri[2 * k] | (ri[2 * k + 1] << 16);
            TOT[sc * 128 + d] = run; FIRST[sc * 128 + d] = bl[0];
            *(LAS v4u*)(IT + d * HP_VS + sc * 32) = (v4u){ipk[0], ipk[1], ipk[2], ipk[3]};
            *(LAS v4u*)(IT + d * HP_VS + sc * 32 + 16) = (v4u){ipk[4], ipk[5], ipk[6], ipk[7]};
            HG_BAR(); HT_MARK(0);
            HGC_FLUSH();
            if (unit + G < HG_UNITS) HGC_LOAD(unit + G);
            float pre = 0.f, b16[4]; { float cum = 0.f;
#pragma unroll
              for (int s4 = 0; s4 < 4; ++s4) { if (s4 == sc) pre = cum; b16[s4] = cum + FIRST[s4 * 128 + d]; cum += TOT[s4 * 128 + d]; } }
            const float bref = pre + bl[0];
            const float qdown = __builtin_amdgcn_exp2f(bref);
            float cI[4];
#pragma unroll
            for (int I = 1; I < 4; ++I) cI[I] = __builtin_amdgcn_exp2f(b16[I] - b16[I - 1]);
#pragma unroll
            for (int tt = 0; tt < 16; ++tt) { const float bt = pre + bl[tt]; const int t = sc * 16 + tt;
                const float qt = qf[tt] * __builtin_amdgcn_exp2f(bt - bref);
                *(LAS bf16*)(QT + t * HP_TD + d * 2) = (bf16)pkbf(qt, qt);
                *(LAS bf16*)(QH + t * HP_TD + d * 2) = (bf16)pkbf(qt * qdown, qt * qdown);
                float kt = kf[tt] * __builtin_amdgcn_exp2f(fminf(bref - bt, 80.0f));
#pragma unroll
                for (int I = 0; I < 4; ++I) if (I >= sc) { if (I > sc) kt *= cI[I]; *(LAS bf16*)(KTI + (8 * I * (I + 1) + t) * HP_TD + d * 2) = (bf16)pkbf(kt, kt); } }
            HG_BAR(); HT_MARK(1);
        }
#pragma unroll
        for (int rep = 0; rep < 2; ++rep) { const int blk = wave + 8 * rep, I = blk >> 2, J = blk & 3;
            f32x4v a = (f32x4v){0.f, 0.f, 0.f, 0.f};
            if (J <= I) { bf16x8 af[4], bq[4];
#pragma unroll
                for (int kb = 0; kb < 4; ++kb) { af[kb] = *(const LAS bf16x8*)(KTI + (8 * I * (I + 1) + 16 * J + lr) * HP_TD + kb * 64 + lq * 16);
                    bq[kb] = *(const LAS bf16x8*)(QT + (16 * I + lr) * HP_TD + kb * 64 + lq * 16); }
#pragma unroll
                for (int kb = 0; kb < 4; ++kb) asm volatile("" : "+v"(af[kb]), "+v"(bq[kb]));
#pragma unroll
                for (int kb = 0; kb < 4; ++kb) a = mfma16(af[kb], bq[kb], a);
                if (J == I) {
#pragma unroll
                    for (int j = 0; j < 4; ++j) if (4 * lq + j > lr) a[j] = 0.f; }
            }
            *(LAS unsigned long long*)(AT + (16 * I + lr) * HP_VS + (16 * J + 4 * lq) * 2) = (unsigned long long)pkbf(a[0], a[1]) | ((unsigned long long)pkbf(a[2], a[3]) << 32);
        }
        HG_BAR(); HT_MARK(2);
        f32x4v o[4];
        { bf16x8 ai[2], bq[4][4], ba[4][2];
#pragma unroll
          for (int kb = 0; kb < 2; ++kb) ai[kb] = *(const LAS bf16x8*)(IT + (16 * wave + lr) * HP_VS + kb * 64 + lq * 16);
#pragma unroll
          for (int tt = 0; tt < 4; ++tt) {
#pragma unroll
            for (int kb = 0; kb < 4; ++kb) bq[tt][kb] = *(const LAS bf16x8*)(QH + (16 * tt + lr) * HP_TD + kb * 64 + lq * 16);
#pragma unroll
            for (int kb = 0; kb < 2; ++kb) ba[tt][kb] = *(const LAS bf16x8*)(AT + (16 * tt + lr) * HP_VS + kb * 64 + lq * 16); }
#pragma unroll
          for (int tt = 0; tt < 4; ++tt) {
#pragma unroll
            for (int kb = 0; kb < 4; ++kb) asm volatile("" : "+v"(bq[tt][kb]));
#pragma unroll
            for (int kb = 0; kb < 2; ++kb) asm volatile("" : "+v"(ba[tt][kb])); }
#pragma unroll
          for (int tt = 0; tt < 4; ++tt) o[tt] = (f32x4v){0.f, 0.f, 0.f, 0.f};
#pragma unroll
          for (int kb = 0; kb < 4; ++kb)
#pragma unroll
            for (int tt = 0; tt < 4; ++tt) o[tt] = mfma16(sf[kb], bq[tt][kb], o[tt]);
#pragma unroll
          for (int kb = 0; kb < 2; ++kb)
#pragma unroll
            for (int tt = 0; tt < 4; ++tt) o[tt] = mfma16(ai[kb], ba[tt][kb], o[tt]); }
#pragma unroll
        for (int tt = 0; tt < 4; ++tt) { float ss = (o[tt][0] * o[tt][0] + o[tt][1] * o[tt][1]) + (o[tt][2] * o[tt][2] + o[tt][3] * o[tt][3]);
            ss += __shfl_xor(ss, 16); ss += __shfl_xor(ss, 32);
            if (lane < 16) SSQ[wave * 64 + 16 * tt + lane] = ss; }
        HG_BAR(); HT_MARK(3);
        const f32x4 nw = *(const f32x4*)(normw + 16 * wave + 4 * lq);
#pragma unroll
        for (int tt = 0; tt < 4; ++tt) { float tot = 0.f;
#pragma unroll
            for (int w = 0; w < 8; ++w) tot += SSQ[w * 64 + 16 * tt + lr];
            const float r = __builtin_amdgcn_rsqf(tot * (1.0f / HG_D) + NORM_EPS);
            const unsigned glo = (unsigned)gq[tt], ghi = (unsigned)(gq[tt] >> 32);
            const float g0 = bflo(glo), g1 = bfhi(glo), g2 = bflo(ghi), g3 = bfhi(ghi);
            const float y0 = o[tt][0] * r * nw.x * (g0 * sigmoid_f(g0)), y1 = o[tt][1] * r * nw.y * (g1 * sigmoid_f(g1));
            const float y2 = o[tt][2] * r * nw.z * (g2 * sigmoid_f(g2)), y3 = o[tt][3] * r * nw.w * (g3 * sigmoid_f(g3));
            ydef[tt] = (unsigned long long)pkbf(y0, y1) | ((unsigned long long)pkbf(y2, y3) << 32); }
        yp = (bf16*)(ws + out_off) + (rowu + lr) * opitch + ocol + h * HG_D + 16 * wave + 4 * lq;
        HG_BAR(); HT_MARK(4);
    }
    HGC_FLUSH();
#undef HGC_FLUSH
#if defined(PROBE_HT)
    if (lane == 0) { LAS unsigned long long* HTA = (LAS unsigned long long*)(ldsb + LDSCTL_OFF + 14336 + 256) + wave * 6; for (int k = 0; k < 6; ++k) HTA[k] += ht_acc[k]; }
#endif
#undef HT_MARK
}

constexpr size_t WS_SEL = 7 * MiB;
constexpr float MB_C2 = 0.125f * 1.4426950408889634f;
#ifndef MB_SKEW
#define MB_SKEW 0
#endif
#ifndef MB_SWAP
#define MB_SWAP 0
#endif
#ifndef MB_PRIO_ON
#define MB_PRIO_ON 0
#endif
#if MB_PRIO_ON
#define MB_PRIO(p) __builtin_amdgcn_s_setprio(p)
#else
#define MB_PRIO(p) do {} while (0)
#endif
constexpr float MB_THR = 8.0f;
typedef float f32x16 __attribute__((ext_vector_type(16)));
typedef short s16x4 __attribute__((ext_vector_type(4)));
typedef short v4i16_t __attribute__((ext_vector_type(4)));
__device__ __forceinline__ f32x16 mfma32(bf16x8 a, bf16x8 b, f32x16 c) { return __builtin_amdgcn_mfma_f32_32x32x16_bf16(a, b, c, 0, 0, 0); }
__device__ __forceinline__ int crow(int r, int hi) { return (r & 3) + 8 * (r >> 2) + 4 * hi; }
__device__ __forceinline__ void glds16(const void* gsrc, unsigned lds_dst) { unsigned keep;
    asm volatile("s_mov_b32 %0, m0\n\ts_mov_b32 m0, %2\n\ts_nop 0\n\tglobal_load_lds_dwordx4 %1, off\n\ts_mov_b32 m0, %0" : "=&s"(keep) : "v"(gsrc), "s"(lds_dst) : "memory"); }

__device__ __forceinline__ void phase_moba_select(Frame& F) {
    PHASE_IDS(F);
    const bf16* proj = (const bf16*)(ws + WS_BIG + BIG_Q2);
    const float* kmean = (const float*)(ws + WS_KMEAN);
    unsigned* SEL = (unsigned*)(ws + WS_SEL);
    LAS float* km = (LAS float*)(ldsb + RING_OFF);
    for (int task = bid; task < BATCH * MB_H * 8; task += G) {
        const int bh = task >> 3, grp = task & 7, b = bh >> 3, h = bh & 7;
        for (int i = tid; i < MB_NB * MB_D; i += NWAVES * 64) km[i] = kmean[(size_t)bh * MB_NB * MB_D + i];
        __syncthreads();
        const int tpos = grp * 512 + tid, qb = tpos >> 8;
        const bf16* qp = proj + ((size_t)b * SEQ + tpos) * Q2W + h * MB_D;
        float q[64];
#pragma unroll
        for (int c = 0; c < 8; ++c) { const v4u qv = *(const v4u*)(qp + c * 8);
            q[c * 8 + 0] = bflo(qv.x); q[c * 8 + 1] = bfhi(qv.x); q[c * 8 + 2] = bflo(qv.y); q[c * 8 + 3] = bfhi(qv.y); q[c * 8 + 4] = bflo(qv.z); q[c * 8 + 5] = bfhi(qv.z); q[c * 8 + 6] = bflo(qv.w); q[c * 8 + 7] = bfhi(qv.w); }
        float g0 = -INFINITY, g1 = -INFINITY, g2 = -INFINITY; int i0 = 0, i1 = 0, i2 = 0;
        for (int n = 0; n < qb; ++n) {
            float s = 0.f;
#pragma unroll
            for (int c = 0; c < 16; ++c) { const f32x4 kv = *(const LAS f32x4*)&km[n * 64 + c * 4]; s += q[c * 4] * kv.x + q[c * 4 + 1] * kv.y + q[c * 4 + 2] * kv.z + q[c * 4 + 3] * kv.w; }
            if (s > g0) { g2 = g1; i2 = i1; g1 = g0; i1 = i0; g0 = s; i0 = n; }
            else if (s > g1) { g2 = g1; i2 = i1; g1 = s; i1 = n; }
            else if (s > g2) { g2 = s; i2 = n; }
        }
        unsigned mask = 0u;
        if (qb >= 1) mask |= 1u << i0;
        if (qb >= 2) mask |= 1u << i1;
        if (qb >= 3) mask |= 1u << i2;
        SEL[(size_t)bh * SEQ + tpos] = mask;
        __syncthreads();
    }
}

constexpr int MBL_BUF = 65536, MBL_V = 32768, MBL_WSF = LDSCTL_OFF + 1024;
__device__ __forceinline__ void phase_moba_attn(Frame& F, size_t out_off, int opitch, int ocol) {
    PHASE_IDS(F);
    const bf16* proj = (const bf16*)(ws + WS_BIG + BIG_Q2);
    const unsigned* SEL = (const unsigned*)(ws + WS_SEL);
    const int r32 = lane & 31, hi = lane >> 5;
    const unsigned lds0 = (unsigned)(size_t)ldsb;
    LAS float* wsf = (LAS float*)(ldsb + MBL_WSF) + wave * 64;
    const int vcu = (G % 8 == 0) ? (bid % 8) * (G / 8) + bid / 8 : bid;
    const int nround = (BATCH * MB_H * MB_NB + G - 1) / G;
    const int qg = (wave & 4) ? (wave ^ 2) : wave;
#define MB_UNIT(RND, BH, QB, OK) do { if (G == 256) { const int x_ = vcu >> 5, c_ = vcu & 31, i16_ = c_ & 15, s_ = ((RND) & 2) ? ((i16_ + 8) & 15) : i16_; BH = x_ * 8 + (RND) * 2 + (c_ >> 4); QB = ((RND) & 1) ? 15 - s_ : s_; OK = (RND) < nround; } \
        else { const int U_ = vcu + (RND) * G; OK = (RND) < nround && U_ < BATCH * MB_H * MB_NB; BH = U_ >> 4; QB = U_ & 15; } } while (0)
    bf16x8 qr_n[4]; v4u ks_n[4]; unsigned sel_n = 0u; int par = 0;
#define MB_ULOAD(BH, QB) do { const int tq_ = (QB) * MB_BS + qg * 32 + r32; const bf16* Qw_ = proj + ((size_t)((BH) >> 3) * SEQ + tq_) * Q2W + ((BH) & 7) * MB_D; \
        _Pragma("unroll") for (int d0 = 0; d0 < 4; ++d0) qr_n[d0] = *(const bf16x8*)(Qw_ + d0 * 16 + hi * 8); \
        sel_n = SEL[(size_t)(BH) * SEQ + tq_]; \
        const unsigned char* kself_ = (const unsigned char*)F.xo + zoff_ + KIMG_OFF + (size_t)(BH) * (SEQ / 64) * 8192 + (size_t)(tq_ >> 6) * 8192 + (tq_ & 63) * 16; \
        _Pragma("unroll") for (int d0 = 0; d0 < 4; ++d0) ks_n[d0] = *(const v4u*)(kself_ + (2 * d0 + hi) * 1024); } while (0)
#define MB_DMA2(KS, VS, blk, buf) do { _Pragma("unroll") for (int kt_ = 0; kt_ < 4; ++kt_) { \
        glds16((KS) + (size_t)((blk) * 4 + kt_) * 8192, (unsigned)__builtin_amdgcn_readfirstlane(lds0 + (buf) * MBL_BUF + kt_ * 8192 + wave * 1024)); \
        glds16((VS) + (size_t)((blk) * 4 + kt_) * 8192, (unsigned)__builtin_amdgcn_readfirstlane(lds0 + (buf) * MBL_BUF + MBL_V + kt_ * 8192 + wave * 1024)); } } while (0)
    { int bh0, qb0; bool ok0; MB_UNIT(0, bh0, qb0, ok0);
      if (ok0) { MB_ULOAD(bh0, qb0);
          const unsigned char* ks0 = (const unsigned char*)F.xo + zoff_ + KIMG_OFF + (size_t)bh0 * (SEQ / 64) * 8192 + wave * 1024 + lane * 16;
          const unsigned char* vs0 = (const unsigned char*)F.xo + zoff_ + VIMG_OFF + (size_t)bh0 * (SEQ / 64) * 8192 + wave * 1024 + lane * 16;
          MB_DMA2(ks0, vs0, qb0, 0); } }
#pragma unroll 1
    for (int rnd = 0; rnd < nround; ++rnd) {
        int bh, qb; bool ok_; MB_UNIT(rnd, bh, qb, ok_); if (!ok_) break;
        int bhn = 0, qbn = 0; bool okn = false; MB_UNIT(rnd + 1, bhn, qbn, okn);
        const int b = bh >> 3, h = bh & 7;
#if defined(PROBE_MT)
        unsigned long long mt_pro = 0, mt_comp = 0, mt_wait = 0, mt_epi = 0, mt_prev = __builtin_amdgcn_s_memrealtime();
#endif
        const float slope2 = exp2f(-(float)(h + 1)) * LOG2E;
        bf16x8 abias0 = (bf16x8){0, 0, 0, 0, 0, 0, 0, 0}, abias1 = abias0, qones = abias0, vones = abias0;
        { const float x0 = slope2 * (float)r32, x1 = slope2 * (float)(r32 + 32);
          const unsigned h0 = f2bf(x0), h1 = f2bf(x1), l0 = f2bf(x0 - __uint_as_float(h0 << 16)), l1 = f2bf(x1 - __uint_as_float(h1 << 16));
          if (hi == 0) { abias0[0] = (short)h0; abias0[1] = (short)l0; abias1[0] = (short)h1; abias1[1] = (short)l1; qones[0] = (short)0x3F80; qones[1] = (short)0x3F80; }
          if (r32 == 0) vones = (bf16x8){(short)0x3F80, (short)0x3F80, (short)0x3F80, (short)0x3F80, (short)0x3F80, (short)0x3F80, (short)0x3F80, (short)0x3F80}; }
        const unsigned char* Kh = (const unsigned char*)F.xo + zoff_ + KIMG_OFF + (size_t)bh * (SEQ / 64) * 8192;
        const unsigned char* Vh = (const unsigned char*)F.xo + zoff_ + VIMG_OFF + (size_t)bh * (SEQ / 64) * 8192;
        {
            const int tq = qb * MB_BS + qg * 32 + r32;
            bf16x8 qr[4];
#pragma unroll
            for (int d0 = 0; d0 < 4; ++d0) qr[d0] = qr_n[d0];
            const unsigned selmask = sel_n;
            const unsigned char* ksrc = Kh + wave * 1024 + lane * 16;
            const unsigned char* vsrc = Vh + wave * 1024 + lane * 16;
            float m_run;
            { float acc = 0.f;
#pragma unroll
              for (int d0 = 0; d0 < 4; ++d0) { const v4u kv = ks_n[d0]; const v4u qv = __builtin_bit_cast(v4u, qr[d0]);
                  acc += bflo(kv.x) * bflo(qv.x) + bfhi(kv.x) * bfhi(qv.x) + bflo(kv.y) * bflo(qv.y) + bfhi(kv.y) * bfhi(qv.y) + bflo(kv.z) * bflo(qv.z) + bfhi(kv.z) * bfhi(qv.z) + bflo(kv.w) * bflo(qv.w) + bfhi(kv.w) * bfhi(qv.w); }
              m_run = acc + __shfl_xor(acc, 32); }
            f32x16 o[2], o2; o[0] = f32x16{}; o[1] = f32x16{}; o2 = f32x16{};
            const int nblk = qb + 1;
            for (int i = 0; i < nblk; ++i) {
#if defined(PROBE_MT)
                { const unsigned long long n_ = __builtin_amdgcn_s_memrealtime(); if (i == 0) mt_pro += n_ - mt_prev; else mt_comp += n_ - mt_prev; mt_prev = n_; }
#endif
                asm volatile("s_waitcnt vmcnt(0)" ::: "memory"); __builtin_amdgcn_s_barrier(); asm volatile("" ::: "memory");
#if defined(PROBE_MT)
                { const unsigned long long n_ = __builtin_amdgcn_s_memrealtime(); mt_wait += n_ - mt_prev; mt_prev = n_; }
#endif
                if (i + 1 < nblk) MB_DMA2(ksrc, vsrc, i, (par + i + 1) & 1);
                else if (okn) {
                    const unsigned char* ksn = (const unsigned char*)F.xo + zoff_ + KIMG_OFF + (size_t)bhn * (SEQ / 64) * 8192 + wave * 1024 + lane * 16;
                    const unsigned char* vsn = (const unsigned char*)F.xo + zoff_ + VIMG_OFF + (size_t)bhn * (SEQ / 64) * 8192 + wave * 1024 + lane * 16;
                    MB_DMA2(ksn, vsn, qbn, (par + i + 1) & 1); }
#if MB_SKEW > 0
                if (wave >= 4) __builtin_amdgcn_s_sleep(MB_SKEW);
#endif
                const bool own = (i == 0); const int j = own ? qb : i - 1;
                const bool lane_on = own || ((selmask >> j) & 1u);
                if (__any(lane_on)) {
                    const int ntile = own ? (qg >> 1) + 1 : 4;
                    const LAS unsigned char* Kb = ldsb + ((par + i) & 1) * MBL_BUF;
                    const LAS unsigned char* Vb0 = ldsb + ((par + i) & 1) * MBL_BUF + MBL_V + ((lane >> 4) & 1) * 32 + (lane & 3) * 8 + (4 * hi + ((lane & 15) >> 2)) * 64;
#define MB_KLOAD(KT) do { const LAS unsigned char* kb_ = Kb + (KT) * 8192 + hi * 1024 + r32 * 16; \
                        _Pragma("unroll") for (int d0 = 0; d0 < 4; ++d0) { kf[2 * d0] = *(const LAS bf16x8*)(kb_ + d0 * 2048); kf[2 * d0 + 1] = *(const LAS bf16x8*)(kb_ + d0 * 2048 + 512); } } while (0)
#define MB_QK(P0, P1, KT) do { const float nb_ = lane_on ? (-slope2 * (float)(tq - (j * MB_BS + (KT) * 64)) - m_run) : -INFINITY; f32x16 cin_; \
                        _Pragma("unroll") for (int r = 0; r < 16; ++r) cin_[r] = nb_; \
                        MB_PRIO(1); P0 = mfma32(abias0, qones, cin_); P1 = mfma32(abias1, qones, cin_); \
                        _Pragma("unroll") for (int d0 = 0; d0 < 4; ++d0) { P0 = mfma32(kf[2 * d0], qr[d0], P0); P1 = mfma32(kf[2 * d0 + 1], qr[d0], P1); } MB_PRIO(0); } while (0)
                    bf16x8 kf[8];
                    f32x16 p0, p1;
#define MB_TILE(KT) do { const int kt = (KT); const int kpos0 = j * MB_BS + kt * 64; const bool more = kt + 1 < ntile; \
                        if (MB_SWAP && wave >= 4 && kt == MB_SWAP) __builtin_amdgcn_s_setprio(1);     \
                        const LAS unsigned char* vbp = Vb0 + kt * 8192; s16x4 vlo[8], vhh[8];     \
                        _Pragma("unroll") for (int d0 = 0; d0 < 2; ++d0) _Pragma("unroll") for (int ks = 0; ks < 4; ++ks) { \
                            vlo[d0 * 4 + ks] = __builtin_bit_cast(s16x4, __builtin_amdgcn_ds_read_tr16_b64_v4i16((LAS v4i16_t*)(vbp + d0 * 4096 + ks * 1024))); \
                            vhh[d0 * 4 + ks] = __builtin_bit_cast(s16x4, __builtin_amdgcn_ds_read_tr16_b64_v4i16((LAS v4i16_t*)(vbp + d0 * 4096 + ks * 1024 + 512))); } \
                        MB_QK(p0, p1, kt); \
                        __builtin_amdgcn_sched_barrier(0); \
                        if (own && 64 * kt + 63 > 32 * qg) { asm volatile("; causal boundary tile" ::: "memory"); const int dq = tq - kpos0 - 4 * hi; \
                            _Pragma("unroll") for (int r = 0; r < 16; ++r) { if (crow(r, 0) > dq) p0[r] = -INFINITY; if (crow(r, 0) + 32 > dq) p1[r] = -INFINITY; } } \
                        float mxa = __builtin_fmaxf(__builtin_fmaxf(p0[0], p0[1]), p1[0]), mxb = __builtin_fmaxf(__builtin_fmaxf(p0[2], p0[3]), p1[1]); mxa = __builtin_fmaxf(__builtin_fmaxf(mxa, p1[2]), p1[3]); \
                        _Pragma("unroll") for (int r = 4; r < 16; r += 4) { mxa = __builtin_fmaxf(__builtin_fmaxf(mxa, p0[r]), p0[r + 1]); mxb = __builtin_fmaxf(__builtin_fmaxf(mxb, p0[r + 2]), p0[r + 3]); \
                            mxa = __builtin_fmaxf(__builtin_fmaxf(mxa, p1[r]), p1[r + 1]); mxb = __builtin_fmaxf(__builtin_fmaxf(mxb, p1[r + 2]), p1[r + 3]); } \
                        float mx = __builtin_fmaxf(mxa, mxb); { const auto rr_ = __builtin_amdgcn_permlane32_swap(__float_as_uint(mx), __float_as_uint(mx), false, false);     \
                            mx = __builtin_fmaxf(__uint_as_float(rr_[0]), __uint_as_float(rr_[1])); } \
                        if (__any(mx > MB_THR)) { asm volatile("; reference raised" ::: "memory"); \
                            const float dl = __builtin_fmaxf(mx, 0.f); m_run += dl; \
                            if (hi == 0) wsf[r32] = __builtin_amdgcn_exp2f(-dl); \
                            _Pragma("unroll") for (int r = 0; r < 16; ++r) { p0[r] -= dl; p1[r] -= dl; } \
                            asm volatile("s_waitcnt lgkmcnt(0)" ::: "memory"); \
                            _Pragma("unroll") for (int r = 0; r < 16; ++r) { const float f = wsf[crow(r, hi)]; o[0][r] *= f; o[1][r] *= f; o2[r] *= f; } } \
                        _Pragma("unroll") for (int r = 0; r < 16; ++r) { p0[r] = __builtin_amdgcn_exp2f(p0[r]); p1[r] = __builtin_amdgcn_exp2f(p1[r]); } \
                        v4u pw0, pw1, pw2, pw3; \
                        pw0 = (v4u){pkbf(p0[0], p0[1]), pkbf(p0[2], p0[3]), pkbf(p0[4], p0[5]), pkbf(p0[6], p0[7])}; \
                        pw1 = (v4u){pkbf(p0[8], p0[9]), pkbf(p0[10], p0[11]), pkbf(p0[12], p0[13]), pkbf(p0[14], p0[15])}; \
                        pw2 = (v4u){pkbf(p1[0], p1[1]), pkbf(p1[2], p1[3]), pkbf(p1[4], p1[5]), pkbf(p1[6], p1[7])}; \
                        pw3 = (v4u){pkbf(p1[8], p1[9]), pkbf(p1[10], p1[11]), pkbf(p1[12], p1[13]), pkbf(p1[14], p1[15])}; \
                        __builtin_amdgcn_sched_barrier(0); \
                        MB_KLOAD(more ? kt + 1 : kt);     \
                        MB_PRIO(1); \
                        o2 = mfma32(__builtin_bit_cast(bf16x8, pw0), vones, o2); o2 = mfma32(__builtin_bit_cast(bf16x8, pw1), vones, o2); \
                        o2 = mfma32(__builtin_bit_cast(bf16x8, pw2), vones, o2); o2 = mfma32(__builtin_bit_cast(bf16x8, pw3), vones, o2); \
                        _Pragma("unroll") for (int d0 = 0; d0 < 2; ++d0) { \
                            o[d0] = mfma32(__builtin_bit_cast(bf16x8, pw0), MB_PK(d0 * 4 + 0), o[d0]); \
                            o[d0] = mfma32(__builtin_bit_cast(bf16x8, pw1), MB_PK(d0 * 4 + 1), o[d0]); \
                            o[d0] = mfma32(__builtin_bit_cast(bf16x8, pw2), MB_PK(d0 * 4 + 2), o[d0]); \
                            o[d0] = mfma32(__builtin_bit_cast(bf16x8, pw3), MB_PK(d0 * 4 + 3), o[d0]); } \
                        MB_PRIO(0); __builtin_amdgcn_sched_barrier(0); } while (0)
#define MB_PK(k) (bf16x8){vlo[k][0], vlo[k][1], vlo[k][2], vlo[k][3], vhh[k][0], vhh[k][1], vhh[k][2], vhh[k][3]}
                    MB_KLOAD(0);
                    __builtin_amdgcn_sched_barrier(0);
#pragma unroll 1
                    for (int kt1 = 0; kt1 < ntile; ++kt1) { MB_TILE(kt1); }
                    if (MB_SWAP && wave >= 4) __builtin_amdgcn_s_setprio(0);
#undef MB_PK
#undef MB_TILE
#undef MB_KLOAD
#undef MB_QK
                }
            }
#if defined(PROBE_MT)
            { const unsigned long long n_ = __builtin_amdgcn_s_memrealtime(); mt_comp += n_ - mt_prev; mt_prev = n_; }
#endif
            if (okn) { MB_ULOAD(bhn, qbn); }
            asm volatile("s_waitcnt lgkmcnt(0)" ::: "memory"); __builtin_amdgcn_s_barrier(); asm volatile("" ::: "memory");
            LAS bf16* stg = (LAS bf16*)(ldsb + ((par + nblk - 1) & 1) * MBL_BUF) + wave * 2048;
#pragma unroll
            for (int r = 0; r < 16; ++r) { const int orow = crow(r, hi);
                const float la = __uint_as_float(__builtin_amdgcn_readlane(__float_as_uint(o2[r]), 0)), lb = __uint_as_float(__builtin_amdgcn_readlane(__float_as_uint(o2[r]), 32)); const float rl = __builtin_amdgcn_rcpf(hi ? lb : la);
                stg[orow * 64 + r32] = (bf16)f2bf(o[0][r] * rl); stg[orow * 64 + 32 + r32] = (bf16)f2bf(o[1][r] * rl); }
            asm volatile("s_waitcnt lgkmcnt(0)" ::: "memory");
            bf16* Ow = (bf16*)(ws + out_off) + ((size_t)b * SEQ + qb * MB_BS + qg * 32) * opitch + ocol + h * MB_D;
#pragma unroll
            for (int i = 0; i < 4; ++i) { const int row = i * 8 + (lane >> 3), ch = lane & 7; const v4u v = *(const LAS v4u*)(stg + row * 64 + ch * 8); *(v4u*)(Ow + (size_t)row * opitch + ch * 8) = v; }
            par = (par + nblk) & 1;
#if defined(PROBE_MT)
            { const unsigned long long n_ = __builtin_amdgcn_s_memrealtime(); mt_epi += n_ - mt_prev;
              if (lane == 0) { LAS unsigned long long* MTA = (LAS unsigned long long*)(ldsb + LDSCTL_OFF + 14336) + wave * 4; MTA[0] += mt_pro; MTA[1] += mt_comp; MTA[2] += mt_wait; MTA[3] += mt_epi; } }
#endif
        }
    }
    asm volatile("s_waitcnt vmcnt(0) lgkmcnt(0)" ::: "memory"); __builtin_amdgcn_s_barrier(); asm volatile("" ::: "memory");
#undef MB_DMA2
#undef MB_ULOAD
#undef MB_UNIT
}

#ifndef HGRN_NAIVE
#define HGRN_NAIVE 0
#endif
#ifndef MOBA_NAIVE
#define MOBA_NAIVE 0
#endif
#ifndef PROBE_GEMM
#define PROBE_GEMM 1
#endif
#ifndef PROBE_G0
#define PROBE_G0 PROBE_GEMM
#endif
#ifndef PROBE_G1
#define PROBE_G1 PROBE_GEMM
#endif
#ifndef PROBE_G2
#define PROBE_G2 PROBE_GEMM
#endif
#ifndef PROBE_G3
#define PROBE_G3 PROBE_GEMM
#endif
#ifndef PROBE_G4
#define PROBE_G4 PROBE_GEMM
#endif
#ifndef PROBE_G5
#define PROBE_G5 PROBE_GEMM
#endif
#ifndef PROBE_G6
#define PROBE_G6 PROBE_GEMM
#endif
#ifndef PROBE_G7
#define PROBE_G7 PROBE_GEMM
#endif
#ifndef GEMM_ALIGN
#define GEMM_ALIGN true
#endif
#ifndef GEMM_SP2
#define GEMM_SP2 true
#endif
#ifndef PROBE_NOATOM
#define PROBE_NOATOM 0
#endif
#ifndef PROBE_NOSUM
#define PROBE_NOSUM 0
#endif
#ifndef PROBE_DUMMY
#define PROBE_DUMMY 0
#endif
#ifndef PROBE_KM
#define PROBE_KM 1
#endif
#ifndef PROBE_BAR
#define PROBE_BAR 0
#endif
#ifndef PROBE_NORM
#define PROBE_NORM 1
#endif
#ifndef PROBE_HGAB
#define PROBE_HGAB 1
#endif
#ifndef PROBE_SEL
#define PROBE_SEL 1
#endif
#ifndef PROBE_CVT
#define PROBE_CVT 1
#endif
#ifndef PROBE_ATTN
#define PROBE_ATTN 1
#endif
#ifndef PROBE_HGC
#define PROBE_HGC 1
#endif
struct Args { const float* in[15]; float* out; unsigned char* ws; };
__global__ void __launch_bounds__(NWAVES * 64, 2) fwd_kernel(Args args) {
    extern __shared__ __attribute__((aligned(16))) unsigned char lds[];
    Frame F;
    F.lds = (LAS unsigned char*)lds;
    F.MISC = (volatile LAS unsigned*)(F.lds + MISC_OFF);
    F.tid = threadIdx.x; F.lane = F.tid & 63; F.wave = __builtin_amdgcn_readfirstlane(F.tid >> 6);
    F.G = gridDim.x; F.ws = args.ws; F.xo = args.out;
    F.ctl = (gu32*)(args.ws + WS_CTL);
    for (int u = F.tid; u < (LDS_BYTES - LDSCTL_OFF) / 4; u += NWAVES * 64) ((LAS unsigned*)(F.lds + LDSCTL_OFF))[u] = 0u;
    __syncthreads();
    XcdBarrier bar = xcd_barrier_post((unsigned*)(F.ctl + CW_BAR), F.MISC + 8);
#define GRID_BAR() xcd_barrier(bar)
#define GRID_BAR_TS(id) do { TS(id); xcd_barrier(bar); TS(8); } while (0)
    unsigned char* ws = args.ws;
    bf16* Hb = (bf16*)(ws + WS_H);
    bf16* BIG = (bf16*)(ws + WS_BIG);
    bf16* MRG = (bf16*)F.xo;
    const bf16* wb = (const bf16*)(ws + WS_W);
    compute_lb(F, args.in[6]);
#if defined(PROBE_TS)
    LAS unsigned long long* TSA = (LAS unsigned long long*)(F.lds + LDSCTL_OFF + 13568);
    if (blockIdx.x == 0 && threadIdx.x == 0) { for (int i_ = 0; i_ < 16; ++i_) TSA[i_] = 0ull; TSA[0] = wall_clock64(); }
#define TS(id) do { if (blockIdx.x == 0 && threadIdx.x == 0) { const unsigned long long n_ = wall_clock64(); TSA[1 + (id)] += n_ - TSA[0]; TSA[0] = n_; } } while (0)
#else
#define TS(id) do { } while (0)
#endif
    unsigned long long* SS = (unsigned long long*)(ws + WS_SS);
    LAS float* RACC = (LAS float*)(F.lds + LDSCTL_OFF + 4096); LAS unsigned* RCNT = (LAS unsigned*)(F.lds + LDSCTL_OFF + 4096 + 4096);
#define GEMM_REP(n) _Pragma("nounroll") for (int rep_ = 0; rep_ < (n); ++rep_)

#pragma nounroll
    for (int l = 0; l < DEPTH; ++l) {
        unsigned long long* ss1 = SS + (size_t)(3 * l + 0) * MROWS; unsigned long long* ss2 = SS + (size_t)(3 * l + 1) * MROWS; unsigned long long* ss3 = SS + (size_t)(3 * l + 2) * MROWS; unsigned long long* ss4 = SS + (size_t)(3 * l + 3) * MROWS;
        _Pragma("nounroll") for (int rep_ = 0; rep_ < PROBE_CVT; ++rep_) phase_convert(F, args.in, l);
        if (l == 0) { _Pragma("nounroll") for (int rep_ = 0; rep_ < PROBE_NORM; ++rep_) phase_xb_ss(F, args.in[0], Hb, ss1); }
        GRID_BAR_TS(0);
#if defined(PROBE_NULLEPI)
#ifndef PROBE_SCHED
#define PROBE_SCHED pg8::StaticOrderC
#endif
        { pg8::Gemm g{Hb, (const bf16*)((const unsigned char*)wb + W_GU1), MROWS, 2 * DFF, DM, DM}; PROBE_SCHED<MROWS, 2 * DFF> S; S.init(F.G, (int)blockIdx.x);
          pg8::EpiNull E{(float*)(ws + WS_END)};
          pg8::gemm_phase<pg8::EpiNull, PROBE_SCHED<MROWS, 2 * DFF>, GEMM_ALIGN, GEMM_SP2, PROBE_NULLEPI, PROBE_NULLEPI, true>(F.lds + RING_OFF, g, S, E); }
#endif
        GEMM_REP(PROBE_G0)
        { pg8::Gemm g{Hb, (const bf16*)((const unsigned char*)wb + W_GU1), MROWS, 2 * DFF, DM, DM}; pg8::StaticOrderC<MROWS, 2 * DFF> S; S.init(F.G, (int)blockIdx.x);
          pg8::EpiSwiGLU E{BIG, DFF, ss1, (PROBE_DUMMY && rep_ + 1 < PROBE_G0) ? ws + WS_END : nullptr};
          pg8::gemm_phase<pg8::EpiSwiGLU, pg8::StaticOrderC<MROWS, 2 * DFF>, GEMM_ALIGN, GEMM_SP2, DM, DM, true>(F.lds + RING_OFF, g, S, E); }
        GRID_BAR_TS(1);
#if defined(PROBE_KDN)
        { pg8::Gemm g{BIG, (const bf16*)((const unsigned char*)wb + W_DN1), MROWS, DM, PROBE_KDN, PROBE_KDN}; pg8::StaticOrderC<MROWS, DM> S; S.init(F.G, (int)blockIdx.x);
          pg8::EpiResid E{Hb, DM, 0.0f, SS + (size_t)7 * MROWS, RACC, RCNT, false};
          pg8::gemm_phase<pg8::EpiResid, pg8::StaticOrderC<MROWS, DM>, GEMM_ALIGN, GEMM_SP2, PROBE_KDN, PROBE_KDN, true>(F.lds + RING_OFF, g, S, E); }
#endif
        GEMM_REP(PROBE_G1)
        { pg8::Gemm g{BIG, (const bf16*)((const unsigned char*)wb + W_DN1), MROWS, DM, DFF, DFF}; pg8::StaticOrderC<MROWS, DM> S; S.init(F.G, (int)blockIdx.x);
          pg8::EpiResid E{Hb, DM, (rep_ + 1 < PROBE_G1) ? 0.0f : 0.5f, (rep_ + 1 < PROBE_G1) ? (PROBE_NOATOM ? nullptr : SS + (size_t)7 * MROWS) : ss2, RACC, RCNT, false};
          pg8::gemm_phase<pg8::EpiResid, pg8::StaticOrderC<MROWS, DM>, GEMM_ALIGN, GEMM_SP2, DFF, DFF, true>(F.lds + RING_OFF, g, S, E); }
        GRID_BAR_TS(2);
        GEMM_REP(PROBE_G2)
        { pg8::Gemm g{Hb, (const bf16*)((const unsigned char*)wb + W_IN), MROWS, DIN, DM, DM}; pg8::StaticOrderC<MROWS, DIN> S; S.init(F.G, (int)blockIdx.x);
          pg8::EpiStoreBf16 E{(unsigned char*)BIG, C_MQ / 256, C_MK / 256, MB_C2, ss2, C_MK / 256, C_MV / 256, (unsigned char*)F.xo + KIMG_OFF, (unsigned char*)F.xo + VIMG_OFF, SEQ};
          pg8::gemm_phase<pg8::EpiStoreBf16, pg8::StaticOrderC<MROWS, DIN>, GEMM_ALIGN, GEMM_SP2, DM, DM, true>(F.lds + RING_OFF, g, S, E); }
        GRID_BAR_TS(3);
        _Pragma("nounroll") for (int rep_ = 0; rep_ < PROBE_KM; ++rep_) phase_kmean(F);
        _Pragma("nounroll") for (int rep_ = 0; rep_ < PROBE_BAR; ++rep_) GRID_BAR();
        _Pragma("nounroll") for (int rep_ = 0; rep_ < PROBE_HGAB; ++rep_) {
        phase_hgrn_A(F, l);
        GRID_BAR_TS(4);
        phase_hgrn_B(F);
        if (rep_ + 1 == PROBE_HGAB) { _Pragma("nounroll") for (int rep2_ = 0; rep2_ < PROBE_SEL; ++rep2_) phase_moba_select(F); }
        GRID_BAR_TS(5);
        }
#if PROBE_ATTN > 1
        phase_moba_attn(F, WS_END, 512, 0);
#endif
        phase_moba_attn(F, WS_BIG + BIG_OAB, DM, 512);
        TS(6);
#if PROBE_HGC > 1
        phase_hgrn_C(F, l, args.in[7] + l * HG_D, WS_END, 512, 0);
#endif
        phase_hgrn_C(F, l, args.in[7] + l * HG_D, WS_BIG + BIG_OAB, DM, 0);
        GRID_BAR_TS(7);
        GEMM_REP(PROBE_G3)
        { const bf16* OAB = (const bf16*)((const unsigned char*)BIG + BIG_OAB);
          pg8::Gemm g{OAB, (const bf16*)((const unsigned char*)wb + W_A), MROWS, DM, DM, DM}; pg8::StaticOrderC<MROWS, DM> S; S.init(F.G, (int)blockIdx.x);
          pg8::EpiGateMerge E{(const unsigned char*)BIG + BIG_GIMG, MRG, DM};
          pg8::gemm_phase<pg8::EpiGateMerge, pg8::StaticOrderC<MROWS, DM>, GEMM_ALIGN, GEMM_SP2, DM, DM>(F.lds + RING_OFF, g, S, E); }
        GRID_BAR_TS(9);
        GEMM_REP(PROBE_G5)
        { pg8::Gemm g{MRG, (const bf16*)((const unsigned char*)wb + W_OUT), MROWS, DM, DM, DM}; pg8::StaticOrderC<MROWS, DM> S; S.init(F.G, (int)blockIdx.x);
          pg8::EpiResid E{Hb, DM, (rep_ + 1 < PROBE_G5) ? 0.0f : 1.0f, (rep_ + 1 < PROBE_G5) ? SS + (size_t)7 * MROWS : ss3, RACC, RCNT, (PROBE_NOSUM && rep_ + 1 < PROBE_G5)};
          pg8::gemm_phase<pg8::EpiResid, pg8::StaticOrderC<MROWS, DM>, GEMM_ALIGN, GEMM_SP2, DM, DM, true>(F.lds + RING_OFF, g, S, E); }
        GRID_BAR_TS(10);
        GEMM_REP(PROBE_G6)
        { pg8::Gemm g{Hb, (const bf16*)((const unsigned char*)wb + W_GU2), MROWS, 2 * DFF, DM, DM}; pg8::StaticOrderC<MROWS, 2 * DFF> S; S.init(F.G, (int)blockIdx.x);
          pg8::EpiSwiGLU E{BIG, DFF, ss3, nullptr};
          pg8::gemm_phase<pg8::EpiSwiGLU, pg8::StaticOrderC<MROWS, 2 * DFF>, GEMM_ALIGN, GEMM_SP2, DM, DM, true>(F.lds + RING_OFF, g, S, E); }
        GRID_BAR_TS(1);
        GEMM_REP(PROBE_G7)
        { pg8::Gemm g{BIG, (const bf16*)((const unsigned char*)wb + W_DN2), MROWS, DM, DFF, DFF}; pg8::StaticOrderC<MROWS, DM> S; S.init(F.G, (int)blockIdx.x);
          pg8::EpiResid E{Hb, DM, (rep_ + 1 < PROBE_G7) ? 0.0f : 0.5f, (rep_ + 1 < PROBE_G7) ? SS + (size_t)7 * MROWS : ss4, RACC, RCNT, false};
          pg8::gemm_phase<pg8::EpiResid, pg8::StaticOrderC<MROWS, DM>, GEMM_ALIGN, GEMM_SP2, DFF, DFF, true>(F.lds + RING_OFF, g, S, E); }
        GRID_BAR_TS(2);
    }
#if defined(PROBE_TS)
    if (blockIdx.x == 0 && threadIdx.x == 0) ((float*)(ws + WS_LB))[4000] = floorf((float)TSA[1 + PROBE_TS] * 0.01f * (1.0f / PROBE_TS_UNIT) * PROBE_TS_Q + 0.5f) * (1.0f / PROBE_TS_Q);
    GRID_BAR();
#endif
#if defined(PROBE_HT)
    if (blockIdx.x == 0) { __syncthreads(); if (threadIdx.x == 0) {
        const unsigned long long q_ = ((LAS unsigned long long*)(F.lds + LDSCTL_OFF + 14336 + 256))[PROBE_HT]; const unsigned long long t0_ = __builtin_amdgcn_s_memrealtime();
        while (__builtin_amdgcn_s_memrealtime() - t0_ < q_ * PROBE_HT_K) __builtin_amdgcn_s_sleep(8); } __syncthreads(); }
#endif
#if defined(PROBE_MT)
    if (blockIdx.x == 0) { __syncthreads(); if (threadIdx.x == 0) {
        const LAS unsigned long long* mta_ = (LAS unsigned long long*)(F.lds + LDSCTL_OFF + 14336) + PROBE_MT_WAVE * 4; const unsigned long long q_ = (PROBE_MT >= 4) ? mta_[0] + mta_[1] + mta_[2] + mta_[3] : mta_[PROBE_MT & 3]; const unsigned long long t0_ = __builtin_amdgcn_s_memrealtime();
        while (__builtin_amdgcn_s_memrealtime() - t0_ < q_ * PROBE_MT_K) __builtin_amdgcn_s_sleep(8); } __syncthreads(); }
#endif
    phase_final_norm(F, Hb, F.xo, args.in[14], SS + (size_t)(3 * DEPTH) * MROWS);
}

extern "C" void kernel_launch(void* const* d_in, const int* in_sizes, int n_in, void* d_out, int out_size, void* d_ws, size_t ws_size, hipStream_t stream) {
    static int grid = 0;
    if (grid == 0) {
        if (n_in != 15 || in_sizes[0] != MROWS * DM || out_size != MROWS * DM || ws_size < WS_END + ((PROBE_ATTN > 1 || PROBE_HGC > 1) ? 32 * MiB : 0)) { fprintf(stderr, "kernel_launch: unexpected shapes (n_in %d, in0 %d, out %d, ws %zu; need ws >= %zu); nothing launched\n", n_in, n_in > 0 ? in_sizes[0] : -1, out_size, ws_size, (size_t)WS_END); grid = -1; return; }
        int dev = 0, cus = 0, per_cu = 0;
        if (hipGetDevice(&dev) != hipSuccess || hipDeviceGetAttribute(&cus, hipDeviceAttributeMultiprocessorCount, dev) != hipSuccess) { grid = -1; return; }
        if (hipFuncSetAttribute((const void*)fwd_kernel, hipFuncAttributeMaxDynamicSharedMemorySize, LDS_BYTES) != hipSuccess) { fprintf(stderr, "kernel_launch: hipFuncSetAttribute failed\n"); grid = -1; return; }
        if (hipOccupancyMaxActiveBlocksPerMultiprocessor(&per_cu, (const void*)fwd_kernel, NWAVES * 64, LDS_BYTES) != hipSuccess || per_cu < 1)
            fprintf(stderr, "kernel_launch: note: occupancy query reports %d workgroups per CU\n", per_cu);
        (void)hipGetLastError();
        grid = cus;
    }
    if (grid < 0) return;
    if (hipMemsetAsync((char*)d_ws + WS_CTL, 0, CTL_ZERO_BYTES, stream) != hipSuccess) { fprintf(stderr, "kernel_launch: memset failed\n"); return; }
    Args a{};
    for (int i = 0; i < 15; ++i) a.in[i] = (const float*)d_in[i];
    a.out = (float*)d_out; a.ws = (unsigned char*)d_ws;
    hipLaunchKernelGGL(fwd_kernel, dim3(grid), dim3(NWAVES * 64), LDS_BYTES, stream, a);
}
```

```cpp
#include <hip/hip_runtime.h>
#include <cstdio>
#include <cstdint>
namespace pg8 {
#define PG8_LAS __attribute__((address_space(3)))
typedef unsigned short bf16_t;
typedef short bf16x8 __attribute__((ext_vector_type(8)));
typedef float f32x4 __attribute__((ext_vector_type(4)));
typedef unsigned u32x4 __attribute__((ext_vector_type(4)));
constexpr int BM = 256, BK = 64, HALF = 128, HTB = HALF * BK * 2  , STAGE_BYTES = 8 * HTB, NXCD = 8, WGM = 8;

__host__ __device__ __forceinline__ int lds_byte(int r, int c) { const int st = (r >> 4) * 2 + (c >> 5), rr = r & 15, cc = c & 31, ob = rr * 64 + cc * 2; return st * 1024 + (ob ^ (((ob >> 9) & 1) << 5)); }
__host__ __device__ __forceinline__ void stage_rc(int b, int& R, int& C) { const int st = b / 1024, sb = b % 1024, swz = sb ^ (((sb >> 9) & 1) << 5); R = (st >> 1) * 16 + swz / 64; C = (st & 1) * 32 + (swz % 64) / 2; }
__host__ __device__ __forceinline__ int perm32(int rho) { const int n = rho >> 4, i = rho & 15; return 8 * (i >> 2) + 4 * n + (i & 3); }

struct Unit { int pm, pn; };
struct Gemm { const bf16_t* A; const bf16_t* Bt; int M, N, K, lda; };

struct StaticOrder {
    int nM, nN, nwg, G, c;
    __host__ __device__ void init(int M, int N, int G_, int c_) { nM = M / BM; nN = N / BM; nwg = nM * nN; G = G_; c = c_; }
    __host__ __device__ bool next(int i, Unit& u) const {
        const long L = (long)i * G + c; if (L >= nwg) return false;
        int wgid = (int)L; { const int q = nwg / NXCD, r = nwg % NXCD, xcd = wgid % NXCD, off = wgid / NXCD; wgid = (xcd < r ? xcd * (q + 1) : r * (q + 1) + (xcd - r) * q) + off; }
        const int nig = WGM * nN, gid = wgid / nig, fm = gid * WGM, gsz = (nM - fm) < WGM ? (nM - fm) : WGM;
        u.pm = fm + ((wgid % nig) % gsz); u.pn = (wgid % nig) / gsz; return true;
    }
    __device__ __forceinline__ void a_ready(const Unit&) const {}
    __device__ __forceinline__ void done(const Unit&) const {}
};

__device__ __forceinline__ unsigned cvt_pk_bf16(float lo, float hi) { unsigned r; asm volatile("v_cvt_pk_bf16_f32 %0, %1, %2" : "=v"(r) : "v"(lo), "v"(hi)); return r; }
typedef float f32x2 __attribute__((ext_vector_type(2)));
__device__ __forceinline__ float bf_lo(unsigned u) { return __uint_as_float(u << 16); }
__device__ __forceinline__ float bf_hi(unsigned u) { return __uint_as_float(u & 0xffff0000u); }
__device__ __forceinline__ float sigm(float x) { return __builtin_amdgcn_rcpf(1.0f + __builtin_amdgcn_exp2f(x * -1.4426950408889634f)); }

__device__ __forceinline__ size_t img_off(int row, int col, int Kc) { return ((size_t)(row >> 7) * (Kc >> 6) + (col >> 6)) * 16384 + (size_t)lds_byte(row & 127, col & 63); }
__device__ __forceinline__ size_t gimg_off(int pm, int pn, int type, int ai, int m, int bj, int wid, int lane) {
    return ((((((((size_t)pm * 4 + pn) * 2 + type) * 2 + ai) * 4 + m) * 2 + bj) * 8 + wid) * 64 + lane) * 16; }
struct PreNone {};
struct PreRow { unsigned long long a, b; };
__device__ __forceinline__ PreRow pre_rows(const unsigned long long* ss, const Unit& u, int wr, int fr, int fq) { const int r = u.pm * BM + wr * 64 + fr + (fq >> 1) * HALF + (fq & 1) * 32; return PreRow{ss[r], ss[r + 16]}; }
__device__ __forceinline__ float pre_get(const PreRow& p, int ai, int m, int fr) { const unsigned long long v = (m & 1) ? p.b : p.a; const int src = fr + 16 * (ai * 2 + (m >> 1));
    const unsigned lo = (unsigned)__shfl((int)(unsigned)v, src), hi = (unsigned)__shfl((int)(unsigned)(v >> 32), src);
    return (float)(((unsigned long long)hi << 32) | lo) * (1.0f / 16777216.0f); }
#if defined(EPI_NT_STORES)
#define EPI_ST16(p, v) __builtin_nontemporal_store((v), (u32x4*)(p))
#else
#define EPI_ST16(p, v) (*(u32x4*)(p) = (v))
#endif
struct EpiStoreBf16 {
    static constexpr bool PERM = true, AFTER_DRAIN = false; static constexpr int MID_T = 0;
    unsigned char* big; int pn_lo, pn_hi; float scale; const unsigned long long* ss; int pn_k, pn_v; unsigned char* kimg; unsigned char* vimg; int seq;
    typedef PreRow Pre;
    __device__ __forceinline__ Pre prefetch(const Unit& u, int wr, int fr, int fq) const { return pre_rows(ss, u, wr, fr, fq); }
    __device__ __forceinline__ void operator()(const f32x4 (&acc)[2][2][4][2], const Unit& u, int wr, int wc, int fr, int fq, const Pre& pre) const {
        const int row0 = u.pm * BM + wr * 64 + fr, col0 = u.pn * BM + wc * 32 + 8 * fq;
        const float sc0 = (u.pn >= pn_lo && u.pn < pn_hi) ? scale : 1.0f;
        float rs[2][4];
#pragma unroll
        for (int ai = 0; ai < 2; ++ai)
#pragma unroll
            for (int m = 0; m < 4; ++m) rs[ai][m] = pre_get(pre, ai, m, fr);
        const int kv_kind = (u.pn >= pn_k && u.pn < pn_k + 2) ? 1 : ((u.pn >= pn_v && u.pn < pn_v + 2) ? 2 : 0);
#pragma unroll
        for (int ai = 0; ai < 2; ++ai)
#pragma unroll
            for (int m = 0; m < 4; ++m) { const int row = row0 + ai * HALF + m * 16;
                const float sc = sc0 * __builtin_amdgcn_rsqf(rs[ai][m] * (1.0f / 1024.0f) + 1e-6f);
                const int b = row / seq, pos = row - b * seq, t = pos >> 6, kv = pos & 63;
#pragma unroll
                for (int bj = 0; bj < 2; ++bj) { const f32x4 v0 = acc[ai][bj][m][0] * sc, v1 = acc[ai][bj][m][1] * sc;
                    u32x4 w; w.x = cvt_pk_bf16(v0[0], v0[1]); w.y = cvt_pk_bf16(v0[2], v0[3]); w.z = cvt_pk_bf16(v1[0], v1[1]); w.w = cvt_pk_bf16(v1[2], v1[3]);
                    if (kv_kind == 0) { const int cg = u.pn * BM + bj * HALF + wc * 32 + 8 * fq;
                        if (u.pn < 8) { const int which = cg >> 9, hh = (cg >> 7) & 3, dd = cg & 127;
                            *(u32x4*)(big + (size_t)which * (32u << 20) + (((size_t)(b * 4 + hh) * seq + pos) * 128 + dd) * 2) = w; }
                        else if (u.pn < 10) *(u32x4*)(big + (size_t)(128u << 20) + ((size_t)row * 512 + (cg - 2048)) * 2) = w;
                        else { unsigned go_ = (unsigned)((ai * 4 + m) * 16384 + bj * 8192); asm volatile("" : "+v"(go_));
                            *(u32x4*)(big + (size_t)(160u << 20) + gimg_off(u.pm, (u.pn - 14) & 3, (u.pn - 14) >> 2, 0, 0, 0, wr * 4 + wc, fr + 16 * fq) + go_) = w; } }
                    else { const int cl = (u.pn - (kv_kind == 1 ? pn_k : pn_v)) * BM + bj * HALF + wc * 32 + 8 * fq, h = cl >> 6, d = cl & 63;
                        const size_t tile = ((size_t)(b * 8 + h) * (seq >> 6) + t) * 8192;
                        if (kv_kind == 1) *(u32x4*)(kimg + tile + (d >> 3) * 1024 + kv * 16) = w;
                        else *(u32x4*)(vimg + tile + ((d >> 5) * 4 + (kv >> 4)) * 1024 + (kv & 15) * 64 + ((d & 31) >> 3) * 16) = w; } } }
    }
};
struct EpiSwiGLU {
    static constexpr bool PERM = true, AFTER_DRAIN = false; static constexpr int MID_T = 0;
    bf16_t* O; int ldc; const unsigned long long* ss; unsigned char* dummy;
    typedef PreRow Pre;
    __device__ __forceinline__ Pre prefetch(const Unit& u, int wr, int fr, int fq) const { return pre_rows(ss, u, wr, fr, fq); }
    __device__ __forceinline__ void operator()(const f32x4 (&acc)[2][2][4][2], const Unit& u, int wr, int wc, int fr, int fq, const Pre& pre) const {
        const int row0 = u.pm * BM + wr * 64 + fr, col0 = u.pn * HALF + wc * 32 + 8 * fq;
        float rs[2][4];
#pragma unroll
        for (int ai = 0; ai < 2; ++ai)
#pragma unroll
            for (int m = 0; m < 4; ++m) rs[ai][m] = pre_get(pre, ai, m, fr);
#pragma unroll
        for (int ai = 0; ai < 2; ++ai)
#pragma unroll
            for (int m = 0; m < 4; ++m) { bf16_t* rowp = (bf16_t*)((unsigned char*)O + img_off(row0 + ai * HALF + m * 16, col0, ldc));
                if (dummy) rowp = (bf16_t*)(dummy + (size_t)blockIdx.x * 16384 + (img_off(row0 + ai * HALF + m * 16, col0, ldc) & 16383));
                const float rr = __builtin_amdgcn_rsqf(rs[ai][m] * (1.0f / 1024.0f) + 1e-6f), rr2 = rr * rr, rrl = rr * -1.4426950408889634f;
                float a[8];
#pragma unroll
                for (int n = 0; n < 2; ++n)
#pragma unroll
                    for (int e = 0; e < 4; ++e) { const float ag = acc[ai][0][m][n][e], au = acc[ai][1][m][n][e];
                        a[n * 4 + e] = (ag * au) * (rr2 * __builtin_amdgcn_rcpf(1.0f + __builtin_amdgcn_exp2f(ag * rrl))); }
                u32x4 w; w.x = cvt_pk_bf16(a[0], a[1]); w.y = cvt_pk_bf16(a[2], a[3]); w.z = cvt_pk_bf16(a[4], a[5]); w.w = cvt_pk_bf16(a[6], a[7]);
                EPI_ST16(rowp, w); }
    }
};
struct EpiResid {
    static constexpr bool PERM = true, AFTER_DRAIN = false; static constexpr int MID_T = 0;
    bf16_t* xb; int ldc; float scale; unsigned long long* ss; PG8_LAS float* racc; PG8_LAS unsigned* rcnt; bool nosum;
    typedef PreNone Pre;
    __device__ __forceinline__ Pre prefetch(const Unit&, int, int, int) const { return Pre{}; }
    __device__ __forceinline__ void operator()(const f32x4 (&acc)[2][2][4][2], const Unit& u, int wr, int wc, int fr, int fq, const Pre&) const {
        const int row0 = u.pm * BM + wr * 64 + fr, col0 = u.pn * BM + wc * 32 + 8 * fq;
#pragma unroll
        for (int ai = 0; ai < 2; ++ai) {
            u32x4 xv[4][2];
#pragma unroll
            for (int m = 0; m < 4; ++m)
#pragma unroll
                for (int bj = 0; bj < 2; ++bj) xv[m][bj] = *(const u32x4*)((const unsigned char*)xb + img_off(row0 + ai * HALF + m * 16, col0 + bj * HALF, ldc));
            float sqm[4];
#pragma unroll
            for (int m = 0; m < 4; ++m) { const int row = row0 + ai * HALF + m * 16; float sq = 0.f;
#pragma unroll
                for (int bj = 0; bj < 2; ++bj) { const u32x4 bv = xv[m][bj];
                    const f32x4 a0 = acc[ai][bj][m][0] * scale, a1 = acc[ai][bj][m][1] * scale;
                    const float v0 = bf_lo(bv.x) + a0[0], v1 = bf_hi(bv.x) + a0[1], v2 = bf_lo(bv.y) + a0[2], v3 = bf_hi(bv.y) + a0[3];
                    const float v4 = bf_lo(bv.z) + a1[0], v5 = bf_hi(bv.z) + a1[1], v6 = bf_lo(bv.w) + a1[2], v7 = bf_hi(bv.w) + a1[3];
                    sq += (v0 * v0 + v1 * v1) + (v2 * v2 + v3 * v3) + (v4 * v4 + v5 * v5) + (v6 * v6 + v7 * v7);
                    u32x4 w; w.x = cvt_pk_bf16(v0, v1); w.y = cvt_pk_bf16(v2, v3); w.z = cvt_pk_bf16(v4, v5); w.w = cvt_pk_bf16(v6, v7);
                    *(u32x4*)((unsigned char*)xb + img_off(row, col0 + bj * HALF, ldc)) = w; }
                sq += __shfl_xor(sq, 16); sq += __shfl_xor(sq, 32); sqm[m] = sq; }
            if (!nosum) {
#pragma unroll
                for (int m = 0; m < 4; ++m) if (fq == 0) racc[((ai * 8 + wr * 4 + m) * 16 + fr) * 4 + wc] = sqm[m];
                asm volatile("s_waitcnt lgkmcnt(0)" ::: "memory");
                const int cg = ai * 2 + wr;
                unsigned old = 0u; if (fr == 0 && fq == 0) old = __hip_atomic_fetch_add(rcnt + cg, 1u, __ATOMIC_RELAXED, __HIP_MEMORY_SCOPE_WORKGROUP);
                old = (unsigned)__builtin_amdgcn_readfirstlane(old);
                if (old == 3u) { const int grp = ai * 8 + wr * 4 + fq; const f32x4 p4 = *(const PG8_LAS f32x4*)(racc + (grp * 16 + fr) * 4); const float tot = ((p4[0] + p4[1]) + p4[2]) + p4[3];
                    if (ss) (void)__hip_atomic_fetch_add(ss + (row0 + ai * HALF + fq * 16), (unsigned long long)(tot * 16777216.0f), __ATOMIC_RELAXED, __HIP_MEMORY_SCOPE_AGENT);
                    if (fr == 0 && fq == 0) rcnt[cg] = 0u; } }
            asm volatile("" ::: "memory"); }
    }
};
template <int MODE> struct EpiGate {
    static constexpr bool PERM = true, AFTER_DRAIN = false; static constexpr int MID_T = 0;
    const bf16_t* G; int ldg; const bf16_t* P; int ldp; bf16_t* O; int ldo;
    typedef PreNone Pre;
    __device__ __forceinline__ Pre prefetch(const Unit&, int, int, int) const { return Pre{}; }
    __device__ __forceinline__ void operator()(const f32x4 (&acc)[2][2][4][2], const Unit& u, int wr, int wc, int fr, int fq, const Pre&) const {
        const int row0 = u.pm * BM + wr * 64 + fr, col0 = u.pn * BM + wc * 32 + 8 * fq;
#pragma unroll
        for (int ai = 0; ai < 2; ++ai)
#pragma unroll
            for (int m = 0; m < 4; ++m) { const size_t row = (size_t)(row0 + ai * HALF + m * 16);
#pragma unroll
                for (int bj = 0; bj < 2; ++bj) { const int c = col0 + bj * HALF;
                    const u32x4 gv = *(const u32x4*)(G + row * ldg + c);
                    const f32x4 v0 = acc[ai][bj][m][0], v1 = acc[ai][bj][m][1];
                    float a[8];
                    a[0] = sigm(bf_lo(gv.x)) * v0[0]; a[1] = sigm(bf_hi(gv.x)) * v0[1]; a[2] = sigm(bf_lo(gv.y)) * v0[2]; a[3] = sigm(bf_hi(gv.y)) * v0[3];
                    a[4] = sigm(bf_lo(gv.z)) * v1[0]; a[5] = sigm(bf_hi(gv.z)) * v1[1]; a[6] = sigm(bf_lo(gv.w)) * v1[2]; a[7] = sigm(bf_hi(gv.w)) * v1[3];
                    if (MODE == 1) { const u32x4 pv = *(const u32x4*)(P + row * ldp + c);
                        a[0] += bf_lo(pv.x); a[1] += bf_hi(pv.x); a[2] += bf_lo(pv.y); a[3] += bf_hi(pv.y); a[4] += bf_lo(pv.z); a[5] += bf_hi(pv.z); a[6] += bf_lo(pv.w); a[7] += bf_hi(pv.w); }
                    u32x4 w; w.x = cvt_pk_bf16(a[0], a[1]); w.y = cvt_pk_bf16(a[2], a[3]); w.z = cvt_pk_bf16(a[4], a[5]); w.w = cvt_pk_bf16(a[6], a[7]);
                    *(u32x4*)(O + row * ldo + c) = w; }
                asm volatile("" ::: "memory"); }
    }
};

struct EpiGateMerge {
    static constexpr bool PERM = true, AFTER_DRAIN = false; static constexpr int MID_T = 8;
    const unsigned char* gimg; bf16_t* O; int ldo;
    typedef PreNone Pre;
    __device__ __forceinline__ Pre prefetch(const Unit&, int, int, int) const { return Pre{}; }
    __device__ __forceinline__ void mid(f32x4 (&acc)[2][2][4][2], const Unit& u, int wr, int wc, int fr, int fq) const {
        const int row0 = u.pm * BM + wr * 64 + fr, col0 = u.pn * BM + wc * 32 + 8 * fq;
        u32x4 ga[2][2][2], gb[2][2][2];
        const unsigned char* gl = gimg + gimg_off(u.pm, u.pn, 0, 0, 0, 0, wr * 4 + wc, fr + 16 * fq);
#define EGM_LOAD(B, SLOT) do { unsigned bo_ = (unsigned)((((B) >> 1) * 4 + ((B) & 1) * 2) * 16384); asm volatile("" : "+v"(bo_));     \
            const unsigned char* pb_ = gl + bo_; \
            _Pragma("unroll") for (int mm = 0; mm < 2; ++mm) _Pragma("unroll") for (int bj = 0; bj < 2; ++bj) { \
                ga[SLOT][mm][bj] = *(const u32x4*)(pb_ + mm * 16384 + bj * 8192); gb[SLOT][mm][bj] = *(const u32x4*)(pb_ + 131072 + mm * 16384 + bj * 8192); } } while (0)
        EGM_LOAD(0, 0);
#pragma unroll
        for (int b = 0; b < 4; ++b) { const int ai = b >> 1, mp = b & 1, sl = b & 1;
            if (b == 0) { EGM_LOAD(1, 1); } else if (b == 1) { EGM_LOAD(2, 0); } else if (b == 2) { EGM_LOAD(3, 1); }
#pragma unroll
            for (int mm = 0; mm < 2; ++mm)
#pragma unroll
                for (int bj = 0; bj < 2; ++bj) { const u32x4 a4 = ga[sl][mm][bj], b4 = gb[sl][mm][bj];
                    const float ea[8] = {bf_lo(a4.x), bf_hi(a4.x), bf_lo(a4.y), bf_hi(a4.y), bf_lo(a4.z), bf_hi(a4.z), bf_lo(a4.w), bf_hi(a4.w)};
                    const float eb[8] = {bf_lo(b4.x), bf_hi(b4.x), bf_lo(b4.y), bf_hi(b4.y), bf_lo(b4.z), bf_hi(b4.z), bf_lo(b4.w), bf_hi(b4.w)};
#pragma unroll
                    for (int e8 = 0; e8 < 8; ++e8) { const float rho = (1.0f + __builtin_amdgcn_exp2f(eb[e8] * -1.4426950408889634f)) * __builtin_amdgcn_rcpf(1.0f + __builtin_amdgcn_exp2f(ea[e8] * -1.4426950408889634f));
                        acc[ai][bj][mp * 2 + mm][e8 >> 2][e8 & 3] *= rho; } }
            asm volatile("" ::: "memory"); }
#undef EGM_LOAD
    }
    __device__ __forceinline__ void operator()(const f32x4 (&acc)[2][2][4][2], const Unit& u, int wr, int wc, int fr, int fq, const Pre&) const {
        const int row0 = u.pm * BM + wr * 64 + fr, col0 = u.pn * BM + wc * 32 + 8 * fq;
#pragma unroll
        for (int ai = 0; ai < 2; ++ai) { unsigned rowv = (unsigned)(row0 + ai * HALF); asm volatile("" : "+v"(rowv));
            unsigned bo_ = (unsigned)(131072 + ai * 65536); asm volatile("" : "+v"(bo_));
            const unsigned char* pb_ = gimg + gimg_off(u.pm, u.pn, 0, 0, 0, 0, wr * 4 + wc, fr + 16 * fq) + bo_;
            u32x4 gb[4][2];
#pragma unroll
            for (int m = 0; m < 4; ++m)
#pragma unroll
                for (int bj = 0; bj < 2; ++bj) gb[m][bj] = *(const u32x4*)(pb_ + m * 16384 + bj * 8192);
#pragma unroll
            for (int m = 0; m < 4; ++m)
#pragma unroll
                for (int bj = 0; bj < 2; ++bj) { const u32x4 gv = gb[m][bj];
                    const f32x4 v0 = acc[ai][bj][m][0], v1 = acc[ai][bj][m][1];
                    float a[8];
                    a[0] = sigm(bf_lo(gv.x)) * v0[0]; a[1] = sigm(bf_hi(gv.x)) * v0[1]; a[2] = sigm(bf_lo(gv.y)) * v0[2]; a[3] = sigm(bf_hi(gv.y)) * v0[3];
                    a[4] = sigm(bf_lo(gv.z)) * v1[0]; a[5] = sigm(bf_hi(gv.z)) * v1[1]; a[6] = sigm(bf_lo(gv.w)) * v1[2]; a[7] = sigm(bf_hi(gv.w)) * v1[3];
                    u32x4 w; w.x = cvt_pk_bf16(a[0], a[1]); w.y = cvt_pk_bf16(a[2], a[3]); w.z = cvt_pk_bf16(a[4], a[5]); w.w = cvt_pk_bf16(a[6], a[7]);
                    *(u32x4*)((unsigned char*)O + img_off((int)rowv + m * 16, col0 + bj * HALF, ldo)) = w; }
            asm volatile("" ::: "memory"); }
    }
};

template <int MC, int NC> struct StaticOrderZero {
    static constexpr int nM = MC / BM, nN = NC / BM, nwg = nM * nN;
    int G, c;
    __device__ __forceinline__ void init(int G_, int c_) { asm volatile("" : "+s"(G_), "+s"(c_)); G = G_; c = c_; }
    __device__ __forceinline__ bool next(int i, Unit& u) const { const int L = i * G + c; if (L >= nwg) return false; u.pm = 0; u.pn = 0; return true; }
    __device__ __forceinline__ void a_ready(const Unit&) const {}
    __device__ __forceinline__ void done(const Unit&) const {}
};
struct EpiNull {
    static constexpr bool PERM = true, AFTER_DRAIN = false; static constexpr int MID_T = 0;
    float* O;
    typedef PreNone Pre;
    __device__ __forceinline__ Pre prefetch(const Unit&, int, int, int) const { return Pre{}; }
    __device__ __forceinline__ void operator()(const f32x4 (&acc)[2][2][4][2], const Unit& u, int wr, int wc, int fr, int fq, const Pre&) const {
        float s = 0.f;
#pragma unroll
        for (int ai = 0; ai < 2; ++ai)
#pragma unroll
            for (int bj = 0; bj < 2; ++bj)
#pragma unroll
                for (int m = 0; m < 4; ++m)
#pragma unroll
                    for (int n = 0; n < 2; ++n) s += (acc[ai][bj][m][n][0] + acc[ai][bj][m][n][1]) + (acc[ai][bj][m][n][2] + acc[ai][bj][m][n][3]);
        O[(size_t)blockIdx.x * 512 + threadIdx.x] = s + (float)(u.pm + u.pn);
    }
};

template <int MC, int NC> struct StaticOrderC {
    static constexpr int nM = MC / BM, nN = NC / BM, nwg = nM * nN;
    int G, c;
    __device__ __forceinline__ void init(int G_, int c_) { asm volatile("" : "+s"(G_), "+s"(c_)); G = G_; c = c_; }
    __device__ __forceinline__ bool next(int i, Unit& u) const {
        const int L = i * G + c; if (L >= nwg) return false;
        int wgid = L; { constexpr int q = nwg / NXCD, r = nwg % NXCD; const int xcd = wgid % NXCD, off = wgid / NXCD; wgid = (xcd < r ? xcd * (q + 1) : r * (q + 1) + (xcd - r) * q) + off; }
        constexpr int nig = WGM * nN; const int gid = wgid / nig, fm = gid * WGM, gsz = (nM - fm) < WGM ? (nM - fm) : WGM;
        u.pm = fm + ((wgid % nig) % gsz); u.pn = (wgid % nig) / gsz; return true;
    }
    __device__ __forceinline__ void a_ready(const Unit&) const {}
    __device__ __forceinline__ void done(const Unit&) const {}
};

template <class Epi, class Sched, bool ALIGN_EPI, bool SP2, int KC, int LDAC, bool AIMG = false>
__device__ __forceinline__ void gemm_phase(PG8_LAS unsigned char* lds, const Gemm g, const Sched& S, const Epi& E) {
    int tid_ = threadIdx.x; asm volatile("" : "+v"(tid_));
    const int tid = tid_, wid = __builtin_amdgcn_readfirstlane(tid >> 6), lane = tid & 63, wr = wid >> 2, wc = wid & 3, fr = lane & 15, fq = lane >> 4;
    constexpr int K = KC, nt = K / BK; static_assert(KC % 128 == 0 && KC >= 256, "K multiple of 128, >= 256");
    unsigned voffA[2], voffB[2];
#pragma unroll
    for (int i = 0; i < 2; ++i) { int R, C; stage_rc(tid * 16 + i * 8192, R, C); const int Rb = Epi::PERM ? ((R & ~31) + perm32(R & 31)) : R;
        voffA[i] = AIMG ? (unsigned)(tid * 16 + i * 8192) : (unsigned)(R * LDAC + C) * 2u; voffB[i] = (unsigned)(tid * 16 + i * 8192); (void)Rb; }
    constexpr size_t kstep = AIMG ? (size_t)16384 : (size_t)(BK * 2);
    constexpr size_t kstepB = 16384;
    constexpr size_t hstepA = AIMG ? (size_t)HALF * K * 2 : (size_t)HALF * LDAC * 2, hstepB = (size_t)HALF * K * 2;
    constexpr size_t tstepA = 2 * hstepA, tstepB = 2 * hstepB;
    const unsigned ldsw = (unsigned)wid * 1024u;
    const int aoff = lds_byte(wr * 64 + fr, fq * 8), boff = lds_byte(wc * 32 + fr, fq * 8);
#define PG8_SA(b, h) (((b) * 2 + (h)) * HTB)
#define PG8_SB(b, h) ((4 + (b) * 2 + (h)) * HTB)
#define PG8_STAGE(bufoff, gbase, voff) do { _Pragma("unroll") for (int _i = 0; _i < 2; ++_i) \
        __builtin_amdgcn_global_load_lds((const unsigned*)((const char*)(gbase) + (voff)[_i]), (PG8_LAS unsigned*)(lds + (bufoff) + ldsw + _i * 8192), 16, 0, 0); } while (0)
#define PG8_LDA(dst, b, h) do { _Pragma("unroll") for (int m = 0; m < 4; ++m) _Pragma("unroll") for (int k = 0; k < 2; ++k) dst[m][k] = *(const PG8_LAS bf16x8*)(lds + PG8_SA(b, h) + aoff + m * 2048 + k * 1024); } while (0)
#define PG8_LDB(dst, b, h) do { _Pragma("unroll") for (int n = 0; n < 2; ++n) _Pragma("unroll") for (int k = 0; k < 2; ++k) dst[n][k] = *(const PG8_LAS bf16x8*)(lds + PG8_SB(b, h) + boff + n * 2048 + k * 1024); } while (0)
#define PG8_MMA(ai, bj, At, Bt) do { __builtin_amdgcn_s_setprio(1); _Pragma("unroll") for (int m = 0; m < 4; ++m) _Pragma("unroll") for (int n = 0; n < 2; ++n) _Pragma("unroll") for (int k = 0; k < 2; ++k) \
        acc[ai][bj][m][n] = __builtin_amdgcn_mfma_f32_16x16x32_bf16(Bt[n][k], At[m][k], acc[ai][bj][m][n], 0, 0, 0); __builtin_amdgcn_s_setprio(0); } while (0)
#define PG8_WAIT_V(n) asm volatile("s_waitcnt vmcnt(" #n ")" ::: "memory")
#define PG8_WAIT_L(n) asm volatile("s_waitcnt lgkmcnt(" #n ")" ::: "memory")
#define PG8_BAR __builtin_amdgcn_s_barrier()
#define PG8_SCHED __builtin_amdgcn_sched_barrier(0)
    Unit cur, nxt; int ui = 0;
#if defined(GEMM_STAGGER_US)
    if (Sched::nN > 4 && ((blockIdx.x >> 3) & 1)) { const unsigned long long t0_ = __builtin_amdgcn_s_memrealtime(); while (__builtin_amdgcn_s_memrealtime() - t0_ < (unsigned long long)(GEMM_STAGGER_US * 100)) __builtin_amdgcn_s_sleep(8); }
#endif
    if (!S.next(0, cur)) return;
    f32x4 acc[2][2][4][2];
#pragma unroll
    for (int a = 0; a < 2; ++a)
#pragma unroll
        for (int b = 0; b < 2; ++b)
#pragma unroll
            for (int m = 0; m < 4; ++m)
#pragma unroll
                for (int n = 0; n < 2; ++n) acc[a][b][m][n] = (f32x4){0.f, 0.f, 0.f, 0.f};
    bf16x8 At[4][2], B0[2][2], B1[2][2];
    const char* cA = (const char*)g.A + (size_t)cur.pm * tstepA; const char* cB = (const char*)g.Bt + (size_t)cur.pn * tstepB;
    S.a_ready(cur);
    if constexpr (SP2) {
        PG8_STAGE(PG8_SB(0, 0), cB, voffB); PG8_STAGE(PG8_SB(0, 1), cB + hstepB, voffB); PG8_STAGE(PG8_SA(0, 0), cA, voffA); PG8_STAGE(PG8_SA(0, 1), cA + hstepA, voffA);
        if (wr == 1) PG8_BAR;
        PG8_WAIT_V(2); PG8_BAR;
        PG8_STAGE(PG8_SB(1, 0), cB + kstepB, voffB); PG8_STAGE(PG8_SA(1, 0), cA + kstep, voffA); PG8_STAGE(PG8_SB(1, 1), cB + hstepB + kstepB, voffB);
        PG8_WAIT_V(6); PG8_BAR;
    } else {
        PG8_STAGE(PG8_SB(0, 0), cB, voffB); PG8_STAGE(PG8_SA(0, 0), cA, voffA); PG8_STAGE(PG8_SB(0, 1), cB + hstepB, voffB); PG8_STAGE(PG8_SA(0, 1), cA + hstepA, voffA);
        if (wr == 1) PG8_BAR;
        PG8_WAIT_V(4); PG8_BAR;
        PG8_STAGE(PG8_SB(1, 0), cB + kstepB, voffB); PG8_STAGE(PG8_SA(1, 0), cA + kstep, voffA); PG8_STAGE(PG8_SB(1, 1), cB + hstepB + kstepB, voffB);
        PG8_WAIT_V(6); PG8_BAR;
    }
    for (;;) {
        const bool has_next = S.next(ui + 1, nxt);
        const typename Epi::Pre pre = E.prefetch(cur, wr, fr, fq);
        const char* nA = has_next ? (const char*)g.A + (size_t)nxt.pm * tstepA : cA; const char* nB = has_next ? (const char*)g.Bt + (size_t)nxt.pn * tstepB : cB;
        for (int t = 0; t < nt; t += 2) {
            const bool last = (t == nt - 2);
            if constexpr (Epi::MID_T > 0) { if (t == Epi::MID_T) E.mid(acc, cur, wr, wc, fr, fq); }
            const char* a1 = cA + (size_t)(t + 1) * kstep;
            const char* a2 = last ? nA : cA + (size_t)(t + 2) * kstep; const char* b2 = last ? nB : cB + (size_t)(t + 2) * kstepB;
            const char* a3 = a2 + kstep; const char* b3 = b2 + kstepB;
            if (last && has_next) S.a_ready(nxt);
            if constexpr (SP2) {
            PG8_LDB(B0, 0, 0); PG8_LDB(B1, 0, 1); PG8_SCHED; PG8_LDA(At, 0, 0); PG8_STAGE(PG8_SA(1, 1), a1 + hstepA, voffA);
            PG8_WAIT_V(8); PG8_WAIT_L(0); PG8_BAR; PG8_MMA(0, 0, At, B0); PG8_MMA(0, 1, At, B1); PG8_BAR; PG8_SCHED;
            PG8_LDA(At, 0, 1); PG8_STAGE(PG8_SB(0, 0), b2, voffB); PG8_STAGE(PG8_SB(0, 1), b2 + hstepB, voffB); PG8_STAGE(PG8_SA(0, 0), a2, voffA);
            PG8_WAIT_V(8); PG8_WAIT_L(0); PG8_BAR; PG8_MMA(1, 0, At, B0); PG8_MMA(1, 1, At, B1); PG8_BAR; PG8_SCHED;
            PG8_LDB(B0, 1, 0); PG8_LDB(B1, 1, 1); PG8_SCHED; PG8_LDA(At, 1, 0); PG8_STAGE(PG8_SA(0, 1), a2 + hstepA, voffA);
            PG8_WAIT_V(8); PG8_WAIT_L(0); PG8_BAR; PG8_MMA(0, 0, At, B0); PG8_MMA(0, 1, At, B1); PG8_BAR; PG8_SCHED;
            PG8_LDA(At, 1, 1); PG8_STAGE(PG8_SB(1, 0), b3, voffB); PG8_STAGE(PG8_SB(1, 1), b3 + hstepB, voffB); PG8_STAGE(PG8_SA(1, 0), a3, voffA);
            PG8_WAIT_V(8); PG8_WAIT_L(0); PG8_BAR; PG8_MMA(1, 0, At, B0); PG8_MMA(1, 1, At, B1); PG8_BAR; PG8_SCHED;
            } else {
            PG8_LDB(B0, 0, 0); PG8_SCHED; PG8_LDA(At, 0, 0); PG8_STAGE(PG8_SA(1, 1), a1 + hstepA, voffA);
            PG8_WAIT_L(8); PG8_BAR; PG8_WAIT_L(0); PG8_MMA(0, 0, At, B0); PG8_BAR; PG8_SCHED;
            PG8_LDB(B1, 0, 1); PG8_STAGE(PG8_SB(0, 0), b2, voffB);
            PG8_BAR; PG8_WAIT_L(0); PG8_MMA(0, 1, At, B1); PG8_BAR;
            PG8_LDA(At, 0, 1); PG8_STAGE(PG8_SA(0, 0), a2, voffA);
            PG8_BAR; PG8_WAIT_L(0); PG8_MMA(1, 0, At, B0); PG8_BAR; PG8_SCHED;
            PG8_STAGE(PG8_SB(0, 1), b2 + hstepB, voffB);
            PG8_WAIT_V(6); PG8_BAR; PG8_MMA(1, 1, At, B1); PG8_BAR;
            PG8_LDB(B0, 1, 0); PG8_SCHED; PG8_LDA(At, 1, 0); PG8_STAGE(PG8_SA(0, 1), a2 + hstepA, voffA);
            PG8_WAIT_L(8); PG8_BAR; PG8_WAIT_L(0); PG8_MMA(0, 0, At, B0); PG8_BAR; PG8_SCHED;
            PG8_LDB(B1, 1, 1); PG8_STAGE(PG8_SB(1, 0), b3, voffB);
            PG8_BAR; PG8_WAIT_L(0); PG8_MMA(0, 1, At, B1); PG8_BAR;
            PG8_LDA(At, 1, 1); PG8_STAGE(PG8_SA(1, 0), a3, voffA);
            PG8_BAR; PG8_WAIT_L(0); PG8_MMA(1, 0, At, B0); PG8_BAR; PG8_SCHED;
            PG8_STAGE(PG8_SB(1, 1), b3 + hstepB, voffB);
            PG8_WAIT_V(6); PG8_BAR; PG8_MMA(1, 1, At, B1); PG8_BAR;
            }
        }
        if constexpr (ALIGN_EPI) { if (wr == 0) PG8_BAR; }
        if constexpr (!Epi::AFTER_DRAIN) { E(acc, cur, wr, wc, fr, fq, pre); S.done(cur); }
        if (!has_next) break;
#pragma unroll
        for (int a = 0; a < 2; ++a)
#pragma unroll
            for (int b = 0; b < 2; ++b)
#pragma unroll
                for (int m = 0; m < 4; ++m)
#pragma unroll
                    for (int n = 0; n < 2; ++n) acc[a][b][m][n] = (f32x4){0.f, 0.f, 0.f, 0.f};
        cur = nxt; cA = nA; cB = nB; ++ui;
        if constexpr (ALIGN_EPI) { if (wr == 1) PG8_BAR; }
    }
    PG8_WAIT_V(0);
    if constexpr (!ALIGN_EPI) { if (wr == 0) PG8_BAR; }
    PG8_BAR;
    if constexpr (Epi::AFTER_DRAIN) { E.fused(acc, cur, wr, wc, fr, fq, lds, wid, lane); S.done(cur); }
#undef PG8_SA
#undef PG8_SB
#undef PG8_STAGE
#undef PG8_LDA
#undef PG8_LDB
#undef PG8_MMA
#undef PG8_WAIT_V
#undef PG8_WAIT_L
#undef PG8_BAR
#undef PG8_SCHED
}
}
#define GAS __attribute__((address_space(1)))
#define LAS __attribute__((address_space(3)))
typedef unsigned short bf16;
typedef unsigned v4u __attribute__((ext_vector_type(4)));
typedef float f32x4 __attribute__((ext_vector_type(4)));
typedef short bf16x8 __attribute__((ext_vector_type(8)));
typedef GAS unsigned gu32;
typedef GAS unsigned long long gu64;
#define RLX_AGENT __ATOMIC_RELAXED, __HIP_MEMORY_SCOPE_AGENT
#define LDS_WAIT() asm volatile("s_waitcnt lgkmcnt(0)" ::: "memory")
#define VM_WAIT() asm volatile("s_waitcnt vmcnt(0)" ::: "memory")
__device__ __forceinline__ unsigned long long rt() { return __builtin_amdgcn_s_memrealtime(); }
__device__ __forceinline__ unsigned f2bf(float f) { unsigned u = __builtin_bit_cast(unsigned, f); return (u + 0x7fffu + ((u >> 16) & 1u)) >> 16; }
__device__ __forceinline__ unsigned pk2(float lo, float hi) { return f2bf(lo) | (f2bf(hi) << 16); }
#define XB_TMO      128
#define XB_XCNT(j)  (256  + 64 * (j))
#define XB_XSUB(j)  (1280 + 64 * (j))
#define XB_XGEN(j)  (2304 + 64 * (j))
#define XB_TOP      3328
#define XB_TOPGEN   3392
#define XCD_BAR_WORDS 3456
#define XB_SPIN_CAP (1u << 18)

__device__ __forceinline__ unsigned xb_ld(unsigned* p)              { return __hip_atomic_load(p, __ATOMIC_RELAXED, __HIP_MEMORY_SCOPE_AGENT); }
__device__ __forceinline__ unsigned xb_add(unsigned* p, unsigned v) { return __hip_atomic_fetch_add(p, v, __ATOMIC_RELAXED, __HIP_MEMORY_SCOPE_AGENT); }
__device__ __forceinline__ unsigned xb_xcc_id() { return (unsigned)__builtin_amdgcn_s_getreg((3 << 11) | 20) & 0xFu; }
#define XB_SPIN(cond, bar) do { unsigned _sp = 0; while (cond) { __builtin_amdgcn_s_sleep(1); \
    if ((++_sp & 255u) == 0u) { if (xb_ld(&(bar)[XB_TMO])) break; if (_sp > XB_SPIN_CAP) { atomicAdd(&(bar)[XB_TMO], 1u); break; } } } } while (0)

struct XcdBarrier {
    unsigned* bar; unsigned x;
    volatile LAS unsigned* st;
};

__device__ __forceinline__ XcdBarrier xcd_barrier_post(unsigned* bar, volatile LAS unsigned* st) {
    XcdBarrier b; b.bar = bar; b.x = xb_xcc_id(); b.st = st;
    if (threadIdx.x == 0) (void)xb_add(&bar[XB_XCNT(b.x)], 1u);
    return b;
}
__device__ __forceinline__ void xcd_barrier_complete(unsigned* bar, unsigned x, unsigned& nloc, unsigned& nx) {
    const unsigned G = gridDim.x * gridDim.y * gridDim.z;
    unsigned sum, cnt, mine, sp = 0u;
    for (;;) {
        sum = 0u; cnt = 0u; mine = 0u;
        unsigned cv[16];
        { const unsigned char* cb_ = (const unsigned char*)&bar[XB_XCNT(8)];
          asm volatile("global_load_dword %0, %16, off offset:-2048 sc1\n\tglobal_load_dword %1, %16, off offset:-1792 sc1\n\tglobal_load_dword %2, %16, off offset:-1536 sc1\n\tglobal_load_dword %3, %16, off offset:-1280 sc1\n\t"
                       "global_load_dword %4, %16, off offset:-1024 sc1\n\tglobal_load_dword %5, %16, off offset:-768 sc1\n\tglobal_load_dword %6, %16, off offset:-512 sc1\n\tglobal_load_dword %7, %16, off offset:-256 sc1\n\t"
                       "global_load_dword %8, %16, off sc1\n\tglobal_load_dword %9, %16, off offset:256 sc1\n\tglobal_load_dword %10, %16, off offset:512 sc1\n\tglobal_load_dword %11, %16, off offset:768 sc1\n\t"
                       "global_load_dword %12, %16, off offset:1024 sc1\n\tglobal_load_dword %13, %16, off offset:1280 sc1\n\tglobal_load_dword %14, %16, off offset:1536 sc1\n\tglobal_load_dword %15, %16, off offset:1792 sc1\n\ts_waitcnt vmcnt(0)"
                       : "=&v"(cv[0]), "=&v"(cv[1]), "=&v"(cv[2]), "=&v"(cv[3]), "=&v"(cv[4]), "=&v"(cv[5]), "=&v"(cv[6]), "=&v"(cv[7]), "=&v"(cv[8]), "=&v"(cv[9]), "=&v"(cv[10]), "=&v"(cv[11]), "=&v"(cv[12]), "=&v"(cv[13]), "=&v"(cv[14]), "=&v"(cv[15])
                       : "v"(cb_) : "memory"); }
#pragma unroll
        for (unsigned j = 0; j < 16; ++j) { const unsigned c = cv[j]; sum += c; cnt += (c > 0u) ? 1u : 0u; mine = (j == x) ? c : mine; }
        if (sum == G) break;
        __builtin_amdgcn_s_sleep(1);
        if ((++sp & 255u) == 0u) { if (xb_ld(&bar[XB_TMO])) break; if (sp > XB_SPIN_CAP) { atomicAdd(&bar[XB_TMO], 1u); break; } }
    }
    nloc = mine > 0u ? mine : 1u; nx = cnt > 0u ? cnt : 1u;
}

__device__ __forceinline__ void xcd_barrier(const XcdBarrier& b) {
    asm volatile("s_waitcnt vmcnt(0)" ::: "memory");
    __syncthreads();
    if (threadIdx.x == 0) {
        unsigned* bar = b.bar;
        __builtin_amdgcn_s_waitcnt(0);
        unsigned nloc = b.st[0], nx = b.st[1];
        if (nloc == 0u) { xcd_barrier_complete(bar, b.x, nloc, nx); b.st[0] = nloc; b.st[1] = nx; }
        const unsigned old = xb_add(&bar[XB_XSUB(b.x)], 1u);
        const unsigned gen = old / nloc;
        if (old + 1u == (gen + 1u) * nloc) {
            __builtin_amdgcn_fence(__ATOMIC_RELEASE, "agent");
            asm volatile("s_waitcnt vmcnt(0)" ::: "memory");
            const unsigned og = xb_add(&bar[XB_TOP], 1u);
            const unsigned tg = og / nx;
            if (og + 1u == (tg + 1u) * nx) xb_add(&bar[XB_TOPGEN], 1u);
            else XB_SPIN(xb_ld(&bar[XB_TOPGEN]) == tg, bar);
            __builtin_amdgcn_fence(__ATOMIC_ACQUIRE, "agent");
            xb_add(&bar[XB_XGEN(b.x)], 1u);
            asm volatile("s_waitcnt vmcnt(0)" ::: "memory");
        } else {
            XB_SPIN(xb_ld(&bar[XB_XGEN(b.x)]) == gen, bar);
            __builtin_amdgcn_fence(__ATOMIC_ACQUIRE, "agent");
            asm volatile("s_waitcnt vmcnt(0)" ::: "memory");
        }
    }
    __syncthreads();
}

constexpr size_t MiB_ = 1u << 20;
constexpr int NWAVES = 8;
constexpr int BATCH = 8, SEQ = 4096, DM = 1024, MROWS = BATCH * SEQ, DEPTH = 2;
constexpr int DFF = 2816, DIN = 5632;
constexpr int HG_H = 4, HG_D = 128, HG_W = 512;
constexpr int MB_H = 8, MB_D = 64, MB_BS = 256, MB_NB = SEQ / MB_BS;
constexpr int C_HQ = 0, C_HF = 512, C_HI = 1024, C_HG = 1536, C_MQ = 2048, C_MK = 2560, C_MV = 3072, C_GA = 3584, C_GB = 4608;
constexpr size_t BIG_HQ = 0, BIG_HF = 32 * MiB_, BIG_HI = 64 * MiB_, BIG_HGT = 96 * MiB_, BIG_Q2 = 128 * MiB_, BIG_GIMG = 160 * MiB_, BIG_OAB = 288 * MiB_;
constexpr int Q2W = 512;
constexpr float NORM_EPS = 1e-6f, MIN_FORGET = 1e-20f, LOG2E = 1.4426950408889634f;

constexpr size_t MiB = 1u << 20;
constexpr size_t WS_CTL = 0, CTL_ZERO_BYTES = 3 * MiB;
constexpr size_t WS_SS = 1 * MiB;
constexpr size_t WS_LB = 5 * MiB;
constexpr size_t WS_KMEAN = 5 * MiB + 65536;
constexpr size_t WS_W = 8 * MiB;
constexpr size_t W_GU1 = 0, W_DN1 = 11 * MiB, W_IN = W_DN1 + 11 * MiB / 2, W_A = W_IN + 11 * MiB, W_B = W_A + 1 * MiB, W_OUT = W_B + 1 * MiB, W_GU2 = W_OUT + 2 * MiB, W_DN2 = W_GU2 + 11 * MiB, W_END = W_DN2 + 11 * MiB / 2;
static_assert(W_END == 48 * MiB, "weight map");
constexpr size_t WS_H = 56 * MiB;
constexpr size_t WS_BIG = 120 * MiB;
constexpr size_t WS_END = WS_BIG + (size_t)MROWS * DIN * 2;
static_assert(WS_END == 472 * MiB, "d_ws map");
constexpr int CW_TMO = 0, CW_BAR = 4096;

constexpr int RING_OFF = 0, RING_BYTES = 131072;
constexpr int LDSCTL_OFF = RING_BYTES, MISC_OFF = LDSCTL_OFF + 320;
constexpr int LDS_BYTES = 147456;
static_assert(MISC_OFF + 128 <= LDS_BYTES, "LDS map");

struct Frame {
    LAS unsigned char* lds;
    volatile LAS unsigned* MISC;
    gu32* ctl;
    int tid, lane, wave, G;
    unsigned char* ws;
    float* xo;
};

#define PHASE_IDS(F) int tid_ = threadIdx.x; asm volatile("" : "+v"(tid_)); const int tid = tid_, lane = tid & 63, wave = __builtin_amdgcn_readfirstlane(tid >> 6); \
    int bid_ = blockIdx.x, G_ = gridDim.x; asm volatile("" : "+s"(bid_), "+s"(G_)); const int bid = bid_, G = G_; \
    unsigned zoff_ = 0u; asm volatile("" : "+s"(zoff_)); unsigned char* ws = (F).ws + zoff_;     LAS unsigned char* ldsb = (F).lds; (void)tid; (void)lane; (void)wave; (void)bid; (void)G; (void)ws; (void)ldsb;
__device__ __forceinline__ float wave_sum(float v) {
#pragma unroll
    for (int o = 1; o < 64; o <<= 1) v += __shfl_xor(v, o);
    return v;
}
__device__ __forceinline__ float wave_max(float v) {
#pragma unroll
    for (int o = 1; o < 64; o <<= 1) v = fmaxf(v, __shfl_xor(v, o));
    return v;
}
__device__ __forceinline__ float bflo(unsigned u) { return __uint_as_float(u << 16); }
__device__ __forceinline__ float bfhi(unsigned u) { return __uint_as_float(u & 0xffff0000u); }
__device__ __forceinline__ float bf1(bf16 u) { return __uint_as_float((unsigned)u << 16); }
__device__ __forceinline__ float sigmoid_f(float x) { return __builtin_amdgcn_rcpf(1.0f + __builtin_amdgcn_exp2f(x * -1.4426950408889634f)); }

template <bool GU>
__device__ __forceinline__ void cvt_block(const float* W, int K, int N, bf16* WT, LAS float* scr, int item, int tid, const float* gain = nullptr, int Kdst = 0, int koff = 0) {
    const int nblk = N / 128, kb = item / nblk, nb = item % nblk, k0 = 64 * kb, n0 = 128 * nb;
    f32x4 v[4]; float gk[4];
#pragma unroll
    for (int i = 0; i < 4; ++i) { const int idx = tid + 512 * i, kk = idx >> 5, n4 = (idx & 31) * 4;
        gk[i] = gain ? gain[k0 + kk] : 1.0f; v[i] = *(const f32x4*)(W + (size_t)(k0 + kk) * N + n0 + n4); }
#pragma unroll
    for (int i = 0; i < 4; ++i) asm volatile("" : "+v"(v[i]), "+v"(gk[i]));
#pragma unroll
    for (int i = 0; i < 4; ++i) { const int idx = tid + 512 * i, kk = idx >> 5, n4 = (idx & 31) * 4;
        LAS float* s = scr + kk * 129 + n4; s[0] = v[i].x * gk[i]; s[1] = v[i].y * gk[i]; s[2] = v[i].z * gk[i]; s[3] = v[i].w * gk[i]; }
    __syncthreads();
    int half = n0 >> 7;
    if (GU) { const int j = (n0 >= DFF) ? n0 - DFF : n0; half = 2 * (j >> 7) + ((n0 >= DFF) ? 1 : 0); }
    const int Kd = Kdst ? Kdst : K; const int kk0 = koff + k0;
    GAS unsigned char* blk = (GAS unsigned char*)WT + ((size_t)half * (Kd >> 6) + (kk0 >> 6)) * 16384;
#pragma unroll
    for (int j = 0; j < 2; ++j) { const int p = tid + 512 * j, R = p >> 3, c = p & 7;
        const int rn = (R & ~31) + pg8::perm32(R & 31); const LAS float* s = scr + (8 * c) * 129 + rn;
        v4u o; o.x = pk2(s[0 * 129], s[1 * 129]); o.y = pk2(s[2 * 129], s[3 * 129]); o.z = pk2(s[4 * 129], s[5 * 129]); o.w = pk2(s[6 * 129], s[7 * 129]);
        *(GAS v4u*)(blk + pg8::lds_byte(R, 8 * c)) = o; }
    __syncthreads();
}
__device__ __forceinline__ void phase_convert(Frame& F, const float* const* in, int l) {
    PHASE_IDS(F);
    LAS float* scr = (LAS float*)(ldsb + RING_OFF);
    constexpr int I_GU = (DM / 64) * (2 * DFF / 128), I_DN = (DFF / 64) * (DM / 128), I_IN = (DM / 64) * (DIN / 128), I_A = (512 / 64) * (DM / 128), I_O = (DM / 64) * (DM / 128);
    constexpr int NITEMS = 2 * I_GU + 2 * I_DN + I_IN + 2 * I_A + I_O;
    unsigned char* wb = ws + WS_W;
    for (int it = bid; it < NITEMS; it += G) {
        int r = it;
        if (r < I_GU) { cvt_block<true>(in[2] + (size_t)l * DM * 2 * DFF, DM, 2 * DFF, (bf16*)(wb + W_GU1), scr, r, tid, in[1] + l * DM); continue; } r -= I_GU;
        if (r < I_GU) { cvt_block<true>(in[12] + (size_t)l * DM * 2 * DFF, DM, 2 * DFF, (bf16*)(wb + W_GU2), scr, r, tid, in[11] + l * DM); continue; } r -= I_GU;
        if (r < I_IN) { cvt_block<false>(in[5] + (size_t)l * DM * DIN, DM, DIN, (bf16*)(wb + W_IN), scr, r, tid, in[4] + l * DM); continue; } r -= I_IN;
        if (r < I_DN) { cvt_block<false>(in[3] + (size_t)l * DFF * DM, DFF, DM, (bf16*)(wb + W_DN1), scr, r, tid); continue; } r -= I_DN;
        if (r < I_DN) { cvt_block<false>(in[13] + (size_t)l * DFF * DM, DFF, DM, (bf16*)(wb + W_DN2), scr, r, tid); continue; } r -= I_DN;
        if (r < I_A) { cvt_block<false>(in[8] + (size_t)l * 512 * DM, 512, DM, (bf16*)(wb + W_A), scr, r, tid, nullptr, 1024, 0); continue; } r -= I_A;
        if (r < I_A) { cvt_block<false>(in[9] + (size_t)l * 512 * DM, 512, DM, (bf16*)(wb + W_A), scr, r, tid, nullptr, 1024, 512); continue; } r -= I_A;
        cvt_block<false>(in[10] + (size_t)l * DM * DM, DM, DM, (bf16*)(wb + W_OUT), scr, r, tid);
    }
}
__device__ __forceinline__ void phase_rmsnorm_bf16(Frame& F, const float* x, const float* gain, bf16* out) {
    PHASE_IDS(F);
    const int gw = bid * NWAVES + wave, NGW = G * NWAVES;
    f32x4 g[4];
#pragma unroll
    for (int j = 0; j < 4; ++j) g[j] = ((const f32x4*)gain)[64 * j + lane];
    for (int m = gw; m < MROWS; m += NGW) {
        const f32x4* xr = (const f32x4*)(x + (size_t)m * DM) + lane;
        f32x4 v[4]; float s = 0.f;
#pragma unroll
        for (int j = 0; j < 4; ++j) { v[j] = xr[64 * j]; s += (v[j].x * v[j].x + v[j].y * v[j].y) + (v[j].z * v[j].z + v[j].w * v[j].w); }
        const float r = 1.0f / sqrtf(wave_sum(s) * (1.0f / DM) + NORM_EPS);
        unsigned long long* o8 = (unsigned long long*)(out + (size_t)m * DM) + lane;
#pragma unroll
        for (int j = 0; j < 4; ++j) o8[64 * j] = (unsigned long long)pk2(v[j].x * r * g[j].x, v[j].y * r * g[j].y) | ((unsigned long long)pk2(v[j].z * r * g[j].z, v[j].w * r * g[j].w) << 32);
    }
}
__device__ __forceinline__ void phase_rmsnorm_f32(Frame& F, float* x, const float* gain) {
    PHASE_IDS(F);
    const int gw = bid * NWAVES + wave, NGW = G * NWAVES;
    f32x4 g[4];
#pragma unroll
    for (int j = 0; j < 4; ++j) g[j] = ((const f32x4*)gain)[64 * j + lane];
    for (int m = gw; m < MROWS; m += NGW) {
        f32x4* xr = (f32x4*)(x + (size_t)m * DM) + lane;
        f32x4 v[4]; float s = 0.f;
#pragma unroll
        for (int j = 0; j < 4; ++j) { v[j] = xr[64 * j]; s += (v[j].x * v[j].x + v[j].y * v[j].y) + (v[j].z * v[j].z + v[j].w * v[j].w); }
        const float r = 1.0f / sqrtf(wave_sum(s) * (1.0f / DM) + NORM_EPS);
#pragma unroll
        for (int j = 0; j < 4; ++j) xr[64 * j] = v[j] * r * g[j];
    }
}

__device__ __forceinline__ void phase_xb_ss(Frame& F, const float* x, bf16* xb, unsigned long long* ss) {
    PHASE_IDS(F);
    const int gw = bid * NWAVES + wave, NGW = G * NWAVES;
    for (int m = gw; m < MROWS; m += NGW) {
        const f32x4* xr = (const f32x4*)(x + (size_t)m * DM) + lane;
        f32x4 v[4]; float s = 0.f;
#pragma unroll
        for (int j = 0; j < 4; ++j) { v[j] = xr[64 * j]; s += (v[j].x * v[j].x + v[j].y * v[j].y) + (v[j].z * v[j].z + v[j].w * v[j].w); }
        s = wave_sum(s);
#pragma unroll
        for (int j = 0; j < 4; ++j) { const int col = 256 * j + 4 * lane;
            *(unsigned long long*)((unsigned char*)xb + pg8::img_off(m, col & ~7, DM) + (col & 4) * 2) = (unsigned long long)pk2(v[j].x, v[j].y) | ((unsigned long long)pk2(v[j].z, v[j].w) << 32); }
        if (lane == 0) ss[m] = (unsigned long long)(s * 16777216.0f);
    }
}
__device__ __forceinline__ void phase_final_norm(Frame& F, const bf16* xb, float* out, const float* gain, const unsigned long long* ss) {
    PHASE_IDS(F);
    const int gw = bid * NWAVES + wave, NGW = G * NWAVES;
    f32x4 g[4];
#pragma unroll
    for (int j = 0; j < 4; ++j) g[j] = ((const f32x4*)gain)[64 * j + lane];
    for (int m = gw; m < MROWS; m += NGW) {
        f32x4* orow = (f32x4*)(out + (size_t)m * DM) + lane;
        const float r = 1.0f / sqrtf((float)ss[m] * (1.0f / 16777216.0f) * (1.0f / DM) + NORM_EPS);
#pragma unroll
        for (int j = 0; j < 4; ++j) { const int col = 256 * j + 4 * lane; const unsigned long long v = *(const unsigned long long*)((const unsigned char*)xb + pg8::img_off(m, col & ~7, DM) + (col & 4) * 2); const unsigned lo = (unsigned)v, hi = (unsigned)(v >> 32);
            f32x4 ov_ = (f32x4){bflo(lo), bfhi(lo), bflo(hi), bfhi(hi)} * r * g[j];
#if defined(PROBE_TS)
            ov_ = ov_ + 0.01f * sqrtf(((const float*)(ws + WS_LB))[4000]);
#endif
            orow[64 * j] = ov_; }
    }
}
__device__ __forceinline__ void compute_lb(Frame& F, const float* logits) {
    PHASE_IDS(F);
    float* lb = (float*)(ws + WS_LB);
    if (bid == 0) {
        const int d = tid;
        float mx = -INFINITY;
        for (int l = 0; l < DEPTH; ++l) mx = fmaxf(mx, logits[l * 512 + d]);
        float den = 0.f;
        for (int l = 0; l < DEPTH; ++l) den += expf(logits[l * 512 + d] - mx);
        const float sm0 = expf(logits[d] - mx) / den;
        float cum = 0.f;
        for (int l = 0; l < DEPTH; ++l) { cum += expf(logits[l * 512 + d] - mx) / den; lb[l * 512 + d] = fminf(fmaxf(cum - sm0, 0.f), 1.f); }
    }
}
constexpr size_t KIMG_OFF = 64 * MiB, VIMG_OFF = 96 * MiB;
__device__ __forceinline__ void phase_kmean(Frame& F) {
    PHASE_IDS(F);
    const unsigned char* kimg = (const unsigned char*)F.xo + KIMG_OFF + zoff_;
    float* kmean = (float*)(ws + WS_KMEAN);
    v4u kc[4] = {}, kn[4] = {};
#define KM_LOAD(dst, T) do { _Pragma("unroll") for (int t = 0; t < 4; ++t) dst[t] = *(const v4u*)(kimg + ((size_t)((T) >> 4) * (SEQ / 64) + ((T) & 15) * 4 + t) * 8192 + wave * 1024 + lane * 16); } while (0)
    if (bid < BATCH * MB_H * MB_NB) KM_LOAD(kc, bid);
    for (int tsk = bid; tsk < BATCH * MB_H * MB_NB; tsk += G) {
        const int bh = tsk >> 4, n = tsk & 15;
        if (tsk + G < BATCH * MB_H * MB_NB) KM_LOAD(kn, tsk + G);
#pragma unroll
        for (int t = 0; t < 4; ++t) asm volatile("" : "+v"(kc[t]));
        float a[8];
#pragma unroll
        for (int j = 0; j < 8; ++j) a[j] = 0.f;
#pragma unroll
        for (int t = 0; t < 4; ++t) { const v4u kv = kc[t];
            a[0] += bflo(kv.x); a[1] += bfhi(kv.x); a[2] += bflo(kv.y); a[3] += bfhi(kv.y); a[4] += bflo(kv.z); a[5] += bfhi(kv.z); a[6] += bflo(kv.w); a[7] += bfhi(kv.w); }
#pragma unroll
        for (int j = 0; j < 8; ++j) a[j] = wave_sum(a[j]);
        if (lane < 8) { float v = a[0];
#pragma unroll
            for (int j = 1; j < 8; ++j) v = (lane == j) ? a[j] : v;
            kmean[((size_t)bh * MB_NB + n) * MB_D + wave * 8 + lane] = v * (1.0f / MB_BS); }
#pragma unroll
        for (int t = 0; t < 4; ++t) kc[t] = kn[t];
    }
#undef KM_LOAD
}

constexpr size_t WS_DC = 6 * MiB;
constexpr int HG_UNITS = BATCH * HG_H * (SEQ / 64);
constexpr int HP_TD = 272, HP_VS = 144;
typedef float f32x4v __attribute__((ext_vector_type(4)));
__device__ __forceinline__ f32x4v mfma16(bf16x8 a, bf16x8 b, f32x4v c) { return __builtin_amdgcn_mfma_f32_16x16x32_bf16(a, b, c, 0, 0, 0); }
typedef float f32x2_t __attribute__((ext_vector_type(2))); typedef __bf16 bf16x2_t __attribute__((ext_vector_type(2)));
__device__ __forceinline__ unsigned pkbf(float lo, float hi) { const f32x2_t v = {lo, hi}; const bf16x2_t b = __builtin_convertvector(v, bf16x2_t); return __builtin_bit_cast(unsigned, b); }

#define HG_PIN(a) do { _Pragma("unroll") for (int p_ = 0; p_ < 16; ++p_) asm volatile("" : "+v"((a)[p_])); } while (0)
#define HG_BAR() do { asm volatile("s_waitcnt lgkmcnt(0)" ::: "memory"); __builtin_amdgcn_s_barrier(); asm volatile("" ::: "memory"); } while (0)
__device__ __forceinline__ void phase_hgrn_A(Frame& F, int l) {
    PHASE_IDS(F);
    const bf16* HF = (const bf16*)(ws + WS_BIG + BIG_HF); const bf16* HI = (const bf16*)(ws + WS_BIG + BIG_HI);
    const float* lbp = (const float*)(ws + WS_LB) + l * 512;
    bf16* ST = (bf16*)((unsigned char*)F.xo + zoff_);
    float* DC = (float*)(ws + WS_DC);
    LAS unsigned char* KT = ldsb; LAS unsigned char* IT = ldsb + 18432; LAS float* TOT = (LAS float*)(ldsb + 36864);
    const int d = tid & 127, sc = tid >> 7;
    unsigned rf[16], ri[16]; float lbn = 0.f;
#define HGA_LOAD(U) do { const int bh_ = (U) >> 6, c_ = (U) & 63; const size_t r0_ = (size_t)(bh_ >> 2) * SEQ + c_ * 64 + sc * 16; \
        const size_t e0_ = ((size_t)bh_ * SEQ + c_ * 64 + sc * 16) * HG_D + d; (void)r0_; const bf16* pf_ = HF + e0_; const bf16* pi_ = HI + e0_;     \
        lbn = lbp[(bh_ & 3) * HG_D + d];     \
        _Pragma("unroll") for (int tt = 0; tt < 16; ++tt) rf[tt] = pf_[(size_t)tt * HG_D]; \
        _Pragma("unroll") for (int tt = 0; tt < 16; ++tt) ri[tt] = pi_[(size_t)tt * HG_D]; } while (0)
    if (bid < HG_UNITS) HGA_LOAD(bid);
    unsigned long long stdef[8]; bf16* stp = nullptr;
#define HGA_FLUSH() do { if (stp) { _Pragma("unroll") for (int a = 0; a < 2; ++a) _Pragma("unroll") for (int v = 0; v < 4; ++v) *(unsigned long long*)(stp + (size_t)(16 * v) * HG_D + 16 * a) = stdef[a * 4 + v]; } } while (0)
    for (int unit = bid; unit < HG_UNITS; unit += G) {
        const int bh = unit >> 6, h = bh & 3; (void)h;
        HG_PIN(rf); HG_PIN(ri); asm volatile("" : "+v"(lbn));
        const float lbv = lbn;
        float bl[16], kf[16]; unsigned ipk[8];
        float run = 0.f;
#pragma unroll
        for (int tt = 0; tt < 16; ++tt) { const float sg = sigmoid_f(__uint_as_float(rf[tt] << 16));
            run += __builtin_amdgcn_logf(fmaxf(lbv + (1.0f - lbv) * sg, MIN_FORGET)); bl[tt] = run; kf[tt] = (1.0f - lbv) * (1.0f - sg); }
#pragma unroll
        for (int k = 0; k < 8; ++k) ipk[k] = ri[2 * k] | (ri[2 * k + 1] << 16);
        TOT[sc * 128 + d] = run;
        *(LAS v4u*)(IT + d * HP_VS + sc * 32) = (v4u){ipk[0], ipk[1], ipk[2], ipk[3]};
        *(LAS v4u*)(IT + d * HP_VS + sc * 32 + 16) = (v4u){ipk[4], ipk[5], ipk[6], ipk[7]};
        HG_BAR();
        HGA_FLUSH();
        if (unit + G < HG_UNITS) HGA_LOAD(unit + G);
        float pre = 0.f, total = 0.f;
#pragma unroll
        for (int s4 = 0; s4 < 4; ++s4) { const float t = TOT[s4 * 128 + d]; total += t; if (s4 < sc) pre += t; }
        unsigned kpk[8];
#pragma unroll
        for (int k = 0; k < 8; ++k) kpk[k] = pkbf(kf[2 * k] * __builtin_amdgcn_exp2f(total - (pre + bl[2 * k])), kf[2 * k + 1] * __builtin_amdgcn_exp2f(total - (pre + bl[2 * k + 1])));
        *(LAS v4u*)(KT + d * HP_VS + sc * 32) = (v4u){kpk[0], kpk[1], kpk[2], kpk[3]};
        *(LAS v4u*)(KT + d * HP_VS + sc * 32 + 16) = (v4u){kpk[4], kpk[5], kpk[6], kpk[7]};
        if (sc == 0) DC[(size_t)unit * HG_D + d] = __builtin_amdgcn_exp2f(total);
        HG_BAR();
        const int dt0 = 2 * (wave & 3), vt0 = 4 * (wave >> 2), lr = lane & 15, lq = lane >> 4;
        f32x4v acc[2][4];
#pragma unroll
        for (int a = 0; a < 2; ++a)
#pragma unroll
            for (int v = 0; v < 4; ++v) acc[a][v] = (f32x4v){0.f, 0.f, 0.f, 0.f};
#pragma unroll
        for (int kb = 0; kb < 2; ++kb) { bf16x8 af[2], bfr[4];
#pragma unroll
            for (int a = 0; a < 2; ++a) af[a] = *(const LAS bf16x8*)(KT + (16 * (dt0 + a) + lr) * HP_VS + kb * 64 + lq * 16);
#pragma unroll
            for (int v = 0; v < 4; ++v) bfr[v] = *(const LAS bf16x8*)(IT + (16 * (vt0 + v) + lr) * HP_VS + kb * 64 + lq * 16);
#pragma unroll
            for (int a = 0; a < 2; ++a)
#pragma unroll
                for (int v = 0; v < 4; ++v) acc[a][v] = mfma16(af[a], bfr[v], acc[a][v]); }
#pragma unroll
        for (int a = 0; a < 2; ++a)
#pragma unroll
            for (int v = 0; v < 4; ++v) stdef[a * 4 + v] = (unsigned long long)pkbf(acc[a][v][0], acc[a][v][1]) | ((unsigned long long)pkbf(acc[a][v][2], acc[a][v][3]) << 32);
        stp = ST + ((size_t)unit * HG_D + 16 * vt0 + lr) * HG_D + 16 * dt0 + 4 * lq;
        HG_BAR();
    }
    HGA_FLUSH();
#undef HGA_FLUSH
}
__device__ __forceinline__ void phase_hgrn_B(Frame& F) {
    PHASE_IDS(F);
    bf16* ST = (bf16*)((unsigned char*)F.xo + zoff_);
    const float* DC = (const float*)(ws + WS_DC);
    for (int e = bid * (NWAVES * 64) + tid; e < BATCH * HG_H * HG_D * (HG_D / 4); e += G * NWAVES * 64) {
        const int bh = e >> 12, rem = e & 4095, v = rem >> 5, dq = (rem & 31) * 4;
        float S0 = 0.f, S1 = 0.f, S2 = 0.f, S3 = 0.f;
        unsigned long long* p = (unsigned long long*)(ST + ((size_t)(bh * 64) * HG_D + v) * HG_D + dq);
        const f32x4* dp = (const f32x4*)(DC + (size_t)(bh * 64) * HG_D + dq);
#pragma unroll 8
        for (int c = 0; c < 64; ++c) {
            const unsigned long long L = p[(size_t)c * (HG_D * HG_D / 4)]; const f32x4 D = dp[(size_t)c * (HG_D / 4)];
            p[(size_t)c * (HG_D * HG_D / 4)] = (unsigned long long)pkbf(S0, S1) | ((unsigned long long)pkbf(S2, S3) << 32);
            const unsigned lo = (unsigned)L, hi = (unsigned)(L >> 32);
            S0 = D.x * S0 + bflo(lo); S1 = D.y * S1 + bfhi(lo); S2 = D.z * S2 + bflo(hi); S3 = D.w * S3 + bfhi(hi);
        }
    }
}
__device__ __forceinline__ void phase_hgrn_C(Frame& F, int l, const float* normw, size_t out_off, int opitch, int ocol) {
    PHASE_IDS(F);
    const bf16* HQ = (const bf16*)(ws + WS_BIG + BIG_HQ); const bf16* HF = (const bf16*)(ws + WS_BIG + BIG_HF); const bf16* HI = (const bf16*)(ws + WS_BIG + BIG_HI); const bf16* HGT = (const bf16*)(ws + WS_BIG + BIG_HGT);
    const float* lbp = (const float*)(ws + WS_LB) + l * 512;
    const bf16* ST = (const bf16*)((unsigned char*)F.xo + zoff_);
    LAS unsigned char* QH = ldsb; LAS unsigned char* QT = ldsb + 17408; LAS unsigned char* KTI = ldsb + 34816; LAS unsigned char* IT = ldsb + 78336; LAS unsigned char* AT = ldsb + 96768;
    LAS float* TOT = (LAS float*)(ldsb + 105984); LAS float* FIRST = (LAS float*)(ldsb + 114176); LAS float* SSQ = (LAS float*)(ldsb + 116224);
    const int cg = tid & 31, tg = tid >> 5, d0 = 4 * cg, t0 = 4 * tg, sc = tid >> 7, lr = lane & 15, lq = lane >> 4;
    unsigned long long rf[4], rq[4], ri[4]; f32x4 lbn = {0.f, 0.f, 0.f, 0.f};
#define HGC_LOAD(U) do { const int bh_ = (U) >> 6, c_ = (U) & 63; \
        const size_t e0_ = ((size_t)bh_ * SEQ + c_ * 64 + t0) * HG_D + d0; const bf16* pq_ = HQ + e0_; const bf16* pf_ = HF + e0_; const bf16* pi_ = HI + e0_; \
        lbn = *(const f32x4*)(lbp + (bh_ & 3) * HG_D + d0); \
        _Pragma("unroll") for (int tt = 0; tt < 4; ++tt) rf[tt] = *(const unsigned long long*)(pf_ + (size_t)tt * HG_D); \
        _Pragma("unroll") for (int tt = 0; tt < 4; ++tt) rq[tt] = *(const unsigned long long*)(pq_ + (size_t)tt * HG_D); \
        _Pragma("unroll") for (int tt = 0; tt < 4; ++tt) ri[tt] = *(const unsigned long long*)(pi_ + (size_t)tt * HG_D); } while (0)
    if (bid < HG_UNITS) HGC_LOAD(bid);
    unsigned long long ydef[4]; bf16* yp = nullptr;
#define HGC_FLUSH() do { if (yp) { _Pragma("unroll") for (int tt = 0; tt < 4; ++tt) *(unsigned long long*)(yp + (size_t)(16 * tt) * opitch) = ydef[tt]; } } while (0)
#if defined(PROBE_HT)
    unsigned long long ht_acc[6] = {0, 0, 0, 0, 0, 0}, ht_prev = __builtin_amdgcn_s_memrealtime();
#define HT_MARK(k) do { const unsigned long long n_ = __builtin_amdgcn_s_memrealtime(); ht_acc[k] += n_ - ht_prev; ht_prev = n_; } while (0)
#else
#define HT_MARK(k) do {} while (0)
#endif
    for (int unit = bid; unit < HG_UNITS; unit += G) {
        const int bh = unit >> 6, c = unit & 63, b = bh >> 2, h = bh & 3;
        const size_t rowu = (size_t)b * SEQ + c * 64;
        bf16x8 sf[4];
#pragma unroll
        for (int kb = 0; kb < 4; ++kb) sf[kb] = *(const bf16x8*)(ST + ((size_t)unit * HG_D + 16 * wave + lr) * HG_D + kb * 32 + lq * 8);
        unsigned long long gq[4];
#pragma unroll
        for (int tt = 0; tt < 4; ++tt) gq[tt] = *(const unsigned long long*)(HGT + ((size_t)bh * SEQ + c * 64 + 16 * tt + lr) * HG_D + 16 * wave + 4 * lq);
        {
#pragma unroll
            for (int tt = 0; tt < 4; ++tt) asm volatile("" : "+v"(rf[tt]), "+v"(rq[tt]), "+v"(ri[tt]));
            asm volatile("" : "+v"(lbn));
            const float lbv[4] = {lbn.x, lbn.y, lbn.z, lbn.w};
            float bl[4][4], kf[4][4], qf[4][4], run[4];
#pragma unroll
            for (int c4 = 0; c4 < 4; ++c4) { run[c4] = 0.f;
#pragma unroll
                for (int tt = 0; tt < 4; ++tt) { const unsigned fw = (unsigned)(rf[tt] >> (32 * (c4 >> 1))), qw = (unsigned)(rq[tt] >> (32 * (c4 >> 1)));
                    const float fv = (c4 & 1) ? __uint_as_float(fw & 0xffff0000u) : __uint_as_float(fw << 16), q = (c4 & 1) ? __uint_as_float(qw & 0xffff0000u) : __uint_as_float(qw << 16);
                    const float sg = sigmoid_f(fv);
                    run[c4] += __builtin_amdgcn_logf(fmaxf(lbv[c4] + (1.0f - lbv[c4]) * sg, MIN_FORGET)); bl[tt][c4] = run[c4]; kf[tt][c4] = (1.0f - lbv[c4]) * (1.0f - sg);
                    qf[tt][c4] = q * sigmoid_f(q); } }
            *(LAS f32x4*)(TOT + tg * 128 + d0) = (f32x4){run[0], run[1], run[2], run[3]};
            if ((tg & 3) == 0) *(LAS f32x4*)(FIRST + sc * 128 + d0) = (f32x4){bl[0][0], bl[0][1], bl[0][2], bl[0][3]};
#pragma unroll
            for (int c4 = 0; c4 < 4; ++c4) { unsigned long long w = 0ull;
#pragma unroll
                for (int tt = 0; tt < 4; ++tt) w |= ((ri[tt] >> (16 * c4)) & 0xffffull) << (16 * tt);
                *(LAS unsigned long long*)(IT + (d0 + c4) * HP_VS + t0 * 2) = w; }
            HG_BAR(); HT_MARK(0);
            HGC_FLUSH();
            if (unit + G < HG_UNITS) HGC_LOAD(unit + G);
            f32x4 pre = {0.f, 0.f, 0.f, 0.f}, b16[4]; { f32x4 cum = {0.f, 0.f, 0.f, 0.f};
#pragma unroll
              for (int g = 0; g < 16; ++g) { if (g == tg) pre = cum; if ((g & 3) == 0) b16[g >> 2] = cum + *(const LAS f32x4*)(FIRST + (g >> 2) * 128 + d0); cum += *(const LAS f32x4*)(TOT + g * 128 + d0); } }
            const f32x4 brefv = (sc == 0) ? b16[0] : (sc == 1) ? b16[1] : (sc == 2) ? b16[2] : b16[3];
            float bref[4] = {brefv.x, brefv.y, brefv.z, brefv.w}, prec[4] = {pre.x, pre.y, pre.z, pre.w}, qdown[4], cI[4][4];
#pragma unroll
            for (int c4 = 0; c4 < 4; ++c4) { qdown[c4] = __builtin_amdgcn_exp2f(bref[c4]);
#pragma unroll
                for (int I = 1; I < 4; ++I) cI[I][c4] = __builtin_amdgcn_exp2f(b16[I][c4] - b16[I - 1][c4]); }
#pragma unroll
            for (int tt = 0; tt < 4; ++tt) { const int t = t0 + tt; float qt[4], kt[4];
#pragma unroll
                for (int c4 = 0; c4 < 4; ++c4) { const float bt = prec[c4] + bl[tt][c4];
                    qt[c4] = qf[tt][c4] * __builtin_amdgcn_exp2f(bt - bref[c4]);
                    kt[c4] = kf[tt][c4] * __builtin_amdgcn_exp2f(fminf(bref[c4] - bt, 80.0f)); }
                *(LAS unsigned long long*)(QT + t * HP_TD + d0 * 2) = (unsigned long long)pkbf(qt[0], qt[1]) | ((unsigned long long)pkbf(qt[2], qt[3]) << 32);
                *(LAS unsigned long long*)(QH + t * HP_TD + d0 * 2) = (unsigned long long)pkbf(qt[0] * qdown[0], qt[1] * qdown[1]) | ((unsigned long long)pkbf(qt[2] * qdown[2], qt[3] * qdown[3]) << 32);
#pragma unroll
                for (int I = 0; I < 4; ++I) if (I >= sc) { if (I > sc) {
#pragma unroll
                        for (int c4 = 0; c4 < 4; ++c4) kt[c4] *= cI[I][c4]; }
                    *(LAS unsigned long long*)(KTI + (8 * I * (I + 1) + t) * HP_TD + d0 * 2) = (unsigned long long)pkbf(kt[0], kt[1]) | ((unsigned long long)pkbf(kt[2], kt[3]) << 32); } }
            HG_BAR(); HT_MARK(1);
        }
#pragma unroll
        for (int rep = 0; rep < 2; ++rep) { const int blk = wave + 8 * rep, I = blk >> 2, J = blk & 3;
            f32x4v a = (f32x4v){0.f, 0.f, 0.f, 0.f};
            if (J <= I) { bf16x8 af[4], bq[4];
#pragma unroll
                for (int kb = 0; kb < 4; ++kb) { af[kb] = *(const LAS bf16x8*)(KTI + (8 * I * (I + 1) + 16 * J + lr) * HP_TD + kb * 64 + lq * 16);
                    bq[kb] = *(const LAS bf16x8*)(QT + (16 * I + lr) * HP_TD + kb * 64 + lq * 16); }
#pragma unroll
                for (int kb = 0; kb < 4; ++kb) asm volatile("" : "+v"(af[kb]), "+v"(bq[kb]));
#pragma unroll
                for (int kb = 0; kb < 4; ++kb) a = mfma16(af[kb], bq[kb], a);
                if (J == I) {
#pragma unroll
                    for (int j = 0; j < 4; ++j) if (4 * lq + j > lr) a[j] = 0.f; }
            }
            *(LAS unsigned long long*)(AT + (16 * I + lr) * HP_VS + (16 * J + 4 * lq) * 2) = (unsigned long long)pkbf(a[0], a[1]) | ((unsigned long long)pkbf(a[2], a[3]) << 32);
        }
        HG_BAR(); HT_MARK(2);
        f32x4v o[4];
        { bf16x8 ai[2], bq[4][4], ba[4][2];
#pragma unroll
          for (int kb = 0; kb < 2; ++kb) ai[kb] = *(const LAS bf16x8*)(IT + (16 * wave + lr) * HP_VS + kb * 64 + lq * 16);
#pragma unroll
          for (int tt = 0; tt < 4; ++tt) {
#pragma unroll
            for (int kb = 0; kb < 4; ++kb) bq[tt][kb] = *(const LAS bf16x8*)(QH + (16 * tt + lr) * HP_TD + kb * 64 + lq * 16);
#pragma unroll
            for (int kb = 0; kb < 2; ++kb) ba[tt][kb] = *(const LAS bf16x8*)(AT + (16 * tt + lr) * HP_VS + kb * 64 + lq * 16); }
#pragma unroll
          for (int tt = 0; tt < 4; ++tt) {
#pragma unroll
            for (int kb = 0; kb < 4; ++kb) asm volatile("" : "+v"(bq[tt][kb]));
#pragma unroll
            for (int kb = 0; kb < 2; ++kb) asm volatile("" : "+v"(ba[tt][kb])); }
#pragma unroll
          for (int tt = 0; tt < 4; ++tt) o[tt] = (f32x4v){0.f, 0.f, 0.f, 0.f};
#pragma unroll
          for (int kb = 0; kb < 4; ++kb)
#pragma unroll
            for (int tt = 0; tt < 4; ++tt) o[tt] = mfma16(sf[kb], bq[tt][kb], o[tt]);
#pragma unroll
          for (int kb = 0; kb < 2; ++kb)
#pragma unroll
            for (int tt = 0; tt < 4; ++tt) o[tt] = mfma16(ai[kb], ba[tt][kb], o[tt]); }
#pragma unroll
        for (int tt = 0; tt < 4; ++tt) { float ss = (o[tt][0] * o[tt][0] + o[tt][1] * o[tt][1]) + (o[tt][2] * o[tt][2] + o[tt][3] * o[tt][3]);
            ss += __shfl_xor(ss, 16); ss += __shfl_xor(ss, 32);
            if (lane < 16) SSQ[wave * 64 + 16 * tt + lane] = ss; }
        HG_BAR(); HT_MARK(3);
        const f32x4 nw = *(const f32x4*)(normw + 16 * wave + 4 * lq);
#pragma unroll
        for (int tt = 0; tt < 4; ++tt) { float tot = 0.f;
#pragma unroll
            for (int w = 0; w < 8; ++w) tot += SSQ[w * 64 + 16 * tt + lr];
            const float r = __builtin_amdgcn_rsqf(tot * (1.0f / HG_D) + NORM_EPS);
            const unsigned glo = (unsigned)gq[tt], ghi = (unsigned)(gq[tt] >> 32);
            const float g0 = bflo(glo), g1 = bfhi(glo), g2 = bflo(ghi), g3 = bfhi(ghi);
            const float y0 = o[tt][0] * r * nw.x * (g0 * sigmoid_f(g0)), y1 = o[tt][1] * r * nw.y * (g1 * sigmoid_f(g1));
            const float y2 = o[tt][2] * r * nw.z * (g2 * sigmoid_f(g2)), y3 = o[tt][3] * r * nw.w * (g3 * sigmoid_f(g3));
            ydef[tt] = (unsigned long long)pkbf(y0, y1) | ((unsigned long long)pkbf(y2, y3) << 32); }
        yp = (bf16*)(ws + out_off) + (rowu + lr) * opitch + ocol + h * HG_D + 16 * wave + 4 * lq;
        HG_BAR(); HT_MARK(4);
    }
    HGC_FLUSH();
#undef HGC_FLUSH
#if defined(PROBE_HT)
    if (lane == 0) { LAS unsigned long long* HTA = (LAS unsigned long long*)(ldsb + LDSCTL_OFF + 14336 + 256) + wave * 6; for (int k = 0; k < 6; ++k) HTA[k] += ht_acc[k]; }
#endif
#undef HT_MARK
}

constexpr size_t WS_SEL = 7 * MiB;
constexpr float MB_C2 = 0.125f * 1.4426950408889634f;
#ifndef MB_SKEW
#define MB_SKEW 0
#endif
#ifndef MB_SWAP
#define MB_SWAP 0
#endif
#ifndef MB_PRIO_ON
#define MB_PRIO_ON 0
#endif
#if MB_PRIO_ON
#define MB_PRIO(p) __builtin_amdgcn_s_setprio(p)
#else
#define MB_PRIO(p) do {} while (0)
#endif
constexpr float MB_THR = 8.0f;
typedef float f32x16 __attribute__((ext_vector_type(16)));
typedef short s16x4 __attribute__((ext_vector_type(4)));
typedef short v4i16_t __attribute__((ext_vector_type(4)));
__device__ __forceinline__ f32x16 mfma32(bf16x8 a, bf16x8 b, f32x16 c) { return __builtin_amdgcn_mfma_f32_32x32x16_bf16(a, b, c, 0, 0, 0); }
__device__ __forceinline__ int crow(int r, int hi) { return (r & 3) + 8 * (r >> 2) + 4 * hi; }
__device__ __forceinline__ void glds16(const void* gsrc, unsigned lds_dst) { unsigned keep;
    asm volatile("s_mov_b32 %0, m0\n\ts_mov_b32 m0, %2\n\ts_nop 0\n\tglobal_load_lds_dwordx4 %1, off\n\ts_mov_b32 m0, %0" : "=&s"(keep) : "v"(gsrc), "s"(lds_dst) : "memory"); }

__device__ __forceinline__ void phase_moba_select(Frame& F) {
    PHASE_IDS(F);
    const bf16* proj = (const bf16*)(ws + WS_BIG + BIG_Q2);
    const float* kmean = (const float*)(ws + WS_KMEAN);
    unsigned* SEL = (unsigned*)(ws + WS_SEL);
    LAS float* km = (LAS float*)(ldsb + RING_OFF);
    for (int task = bid; task < BATCH * MB_H * 8; task += G) {
        const int bh = task >> 3, grp = task & 7, b = bh >> 3, h = bh & 7;
        for (int i = tid; i < MB_NB * MB_D; i += NWAVES * 64) km[i] = kmean[(size_t)bh * MB_NB * MB_D + i];
        __syncthreads();
        const int tpos = grp * 512 + tid, qb = tpos >> 8;
        const bf16* qp = proj + ((size_t)b * SEQ + tpos) * Q2W + h * MB_D;
        float q[64];
#pragma unroll
        for (int c = 0; c < 8; ++c) { const v4u qv = *(const v4u*)(qp + c * 8);
            q[c * 8 + 0] = bflo(qv.x); q[c * 8 + 1] = bfhi(qv.x); q[c * 8 + 2] = bflo(qv.y); q[c * 8 + 3] = bfhi(qv.y); q[c * 8 + 4] = bflo(qv.z); q[c * 8 + 5] = bfhi(qv.z); q[c * 8 + 6] = bflo(qv.w); q[c * 8 + 7] = bfhi(qv.w); }
        float g0 = -INFINITY, g1 = -INFINITY, g2 = -INFINITY; int i0 = 0, i1 = 0, i2 = 0;
        for (int n = 0; n < qb; ++n) {
            float s = 0.f;
#pragma unroll
            for (int c = 0; c < 16; ++c) { const f32x4 kv = *(const LAS f32x4*)&km[n * 64 + c * 4]; s += q[c * 4] * kv.x + q[c * 4 + 1] * kv.y + q[c * 4 + 2] * kv.z + q[c * 4 + 3] * kv.w; }
            if (s > g0) { g2 = g1; i2 = i1; g1 = g0; i1 = i0; g0 = s; i0 = n; }
            else if (s > g1) { g2 = g1; i2 = i1; g1 = s; i1 = n; }
            else if (s > g2) { g2 = s; i2 = n; }
        }
        unsigned mask = 0u;
        if (qb >= 1) mask |= 1u << i0;
        if (qb >= 2) mask |= 1u << i1;
        if (qb >= 3) mask |= 1u << i2;
        SEL[(size_t)bh * SEQ + tpos] = mask;
        __syncthreads();
    }
}

constexpr int MBL_BUF = 65536, MBL_V = 32768, MBL_WSF = LDSCTL_OFF + 1024;
__device__ __forceinline__ void phase_moba_attn(Frame& F, size_t out_off, int opitch, int ocol) {
    PHASE_IDS(F);
    const bf16* proj = (const bf16*)(ws + WS_BIG + BIG_Q2);
    const unsigned* SEL = (const unsigned*)(ws + WS_SEL);
    const int r32 = lane & 31, hi = lane >> 5;
    const unsigned lds0 = (unsigned)(size_t)ldsb;
    LAS float* wsf = (LAS float*)(ldsb + MBL_WSF) + wave * 64;
    const int vcu = (G % 8 == 0) ? (bid % 8) * (G / 8) + bid / 8 : bid;
    const int nround = (BATCH * MB_H * MB_NB + G - 1) / G;
    const int qg = (wave & 4) ? (wave ^ 2) : wave;
#define MB_UNIT(RND, BH, QB, OK) do { if (G == 256) { const int x_ = vcu >> 5, c_ = vcu & 31, i16_ = c_ & 15, s_ = ((RND) & 2) ? ((i16_ + 8) & 15) : i16_; BH = x_ * 8 + (RND) * 2 + (c_ >> 4); QB = ((RND) & 1) ? 15 - s_ : s_; OK = (RND) < nround; } \
        else { const int U_ = vcu + (RND) * G; OK = (RND) < nround && U_ < BATCH * MB_H * MB_NB; BH = U_ >> 4; QB = U_ & 15; } } while (0)
    bf16x8 qr_n[4]; v4u ks_n[4]; unsigned sel_n = 0u; int par = 0;
#define MB_ULOAD(BH, QB) do { const int tq_ = (QB) * MB_BS + qg * 32 + r32; const bf16* Qw_ = proj + ((size_t)((BH) >> 3) * SEQ + tq_) * Q2W + ((BH) & 7) * MB_D; \
        _Pragma("unroll") for (int d0 = 0; d0 < 4; ++d0) qr_n[d0] = *(const bf16x8*)(Qw_ + d0 * 16 + hi * 8); \
        sel_n = SEL[(size_t)(BH) * SEQ + tq_]; \
        const unsigned char* kself_ = (const unsigned char*)F.xo + zoff_ + KIMG_OFF + (size_t)(BH) * (SEQ / 64) * 8192 + (size_t)(tq_ >> 6) * 8192 + (tq_ & 63) * 16; \
        _Pragma("unroll") for (int d0 = 0; d0 < 4; ++d0) ks_n[d0] = *(const v4u*)(kself_ + (2 * d0 + hi) * 1024); } while (0)
#define MB_DMA2(KS, VS, blk, buf) do { _Pragma("unroll") for (int kt_ = 0; kt_ < 4; ++kt_) { \
        glds16((KS) + (size_t)((blk) * 4 + kt_) * 8192, (unsigned)__builtin_amdgcn_readfirstlane(lds0 + (buf) * MBL_BUF + kt_ * 8192 + wave * 1024)); \
        glds16((VS) + (size_t)((blk) * 4 + kt_) * 8192, (unsigned)__builtin_amdgcn_readfirstlane(lds0 + (buf) * MBL_BUF + MBL_V + kt_ * 8192 + wave * 1024)); } } while (0)
    { int bh0, qb0; bool ok0; MB_UNIT(0, bh0, qb0, ok0);
      if (ok0) { MB_ULOAD(bh0, qb0);
          const unsigned char* ks0 = (const unsigned char*)F.xo + zoff_ + KIMG_OFF + (size_t)bh0 * (SEQ / 64) * 8192 + wave * 1024 + lane * 16;
          const unsigned char* vs0 = (const unsigned char*)F.xo + zoff_ + VIMG_OFF + (size_t)bh0 * (SEQ / 64) * 8192 + wave * 1024 + lane * 16;
          MB_DMA2(ks0, vs0, qb0, 0); } }
#pragma unroll 1
    for (int rnd = 0; rnd < nround; ++rnd) {
        int bh, qb; bool ok_; MB_UNIT(rnd, bh, qb, ok_); if (!ok_) break;
        int bhn = 0, qbn = 0; bool okn = false; MB_UNIT(rnd + 1, bhn, qbn, okn);
        const int b = bh >> 3, h = bh & 7;
#if defined(PROBE_MT)
        unsigned long long mt_pro = 0, mt_comp = 0, mt_wait = 0, mt_epi = 0, mt_prev = __builtin_amdgcn_s_memrealtime();
#endif
        const float slope2 = exp2f(-(float)(h + 1)) * LOG2E;
        bf16x8 abias0 = (bf16x8){0, 0, 0, 0, 0, 0, 0, 0}, abias1 = abias0, qones = abias0, vones = abias0;
        { const float x0 = slope2 * (float)r32, x1 = slope2 * (float)(r32 + 32);
          const unsigned h0 = f2bf(x0), h1 = f2bf(x1), l0 = f2bf(x0 - __uint_as_float(h0 << 16)), l1 = f2bf(x1 - __uint_as_float(h1 << 16));
          if (hi == 0) { abias0[0] = (short)h0; abias0[1] = (short)l0; abias1[0] = (short)h1; abias1[1] = (short)l1; qones[0] = (short)0x3F80; qones[1] = (short)0x3F80; }
          if (r32 == 0) vones = (bf16x8){(short)0x3F80, (short)0x3F80, (short)0x3F80, (short)0x3F80, (short)0x3F80, (short)0x3F80, (short)0x3F80, (short)0x3F80}; }
        const unsigned char* Kh = (const unsigned char*)F.xo + zoff_ + KIMG_OFF + (size_t)bh * (SEQ / 64) * 8192;
        const unsigned char* Vh = (const unsigned char*)F.xo + zoff_ + VIMG_OFF + (size_t)bh * (SEQ / 64) * 8192;
        {
            const int tq = qb * MB_BS + qg * 32 + r32;
            bf16x8 qr[4];
#pragma unroll
            for (int d0 = 0; d0 < 4; ++d0) qr[d0] = qr_n[d0];
            const unsigned selmask = sel_n;
            const unsigned char* ksrc = Kh + wave * 1024 + lane * 16;
            const unsigned char* vsrc = Vh + wave * 1024 + lane * 16;
            float m_run;
            { float acc = 0.f;
#pragma unroll
              for (int d0 = 0; d0 < 4; ++d0) { const v4u kv = ks_n[d0]; const v4u qv = __builtin_bit_cast(v4u, qr[d0]);
                  acc += bflo(kv.x) * bflo(qv.x) + bfhi(kv.x) * bfhi(qv.x) + bflo(kv.y) * bflo(qv.y) + bfhi(kv.y) * bfhi(qv.y) + bflo(kv.z) * bflo(qv.z) + bfhi(kv.z) * bfhi(qv.z) + bflo(kv.w) * bflo(qv.w) + bfhi(kv.w) * bfhi(qv.w); }
              m_run = acc + __shfl_xor(acc, 32); }
            f32x16 o[2], o2; o[0] = f32x16{}; o[1] = f32x16{}; o2 = f32x16{};
            const int nblk = qb + 1;
            for (int i = 0; i < nblk; ++i) {
#if defined(PROBE_MT)
                { const unsigned long long n_ = __builtin_amdgcn_s_memrealtime(); if (i == 0) mt_pro += n_ - mt_prev; else mt_comp += n_ - mt_prev; mt_prev = n_; }
#endif
                asm volatile("s_waitcnt vmcnt(0)" ::: "memory"); __builtin_amdgcn_s_barrier(); asm volatile("" ::: "memory");
#if defined(PROBE_MT)
                { const unsigned long long n_ = __builtin_amdgcn_s_memrealtime(); mt_wait += n_ - mt_prev; mt_prev = n_; }
#endif
                if (i + 1 < nblk) MB_DMA2(ksrc, vsrc, i, (par + i + 1) & 1);
                else if (okn) {
                    const unsigned char* ksn = (const unsigned char*)F.xo + zoff_ + KIMG_OFF + (size_t)bhn * (SEQ / 64) * 8192 + wave * 1024 + lane * 16;
                    const unsigned char* vsn = (const unsigned char*)F.xo + zoff_ + VIMG_OFF + (size_t)bhn * (SEQ / 64) * 8192 + wave * 1024 + lane * 16;
                    MB_DMA2(ksn, vsn, qbn, (par + i + 1) & 1); }
#if MB_SKEW > 0
                if (wave >= 4) __builtin_amdgcn_s_sleep(MB_SKEW);
#endif
                const bool own = (i == 0); const int j = own ? qb : i - 1;
                const bool lane_on = own || ((selmask >> j) & 1u);
                if (__any(lane_on)) {
                    const int ntile = own ? (qg >> 1) + 1 : 4;
                    const LAS unsigned char* Kb = ldsb + ((par + i) & 1) * MBL_BUF;
                    const LAS unsigned char* Vb0 = ldsb + ((par + i) & 1) * MBL_BUF + MBL_V + ((lane >> 4) & 1) * 32 + (lane & 3) * 8 + (4 * hi + ((lane & 15) >> 2)) * 64;
#define MB_KLOAD(KT) do { const LAS unsigned char* kb_ = Kb + (KT) * 8192 + hi * 1024 + r32 * 16; \
                        _Pragma("unroll") for (int d0 = 0; d0 < 4; ++d0) { kf[2 * d0] = *(const LAS bf16x8*)(kb_ + d0 * 2048); kf[2 * d0 + 1] = *(const LAS bf16x8*)(kb_ + d0 * 2048 + 512); } } while (0)
#define MB_QK(P0, P1, KT) do { const float nb_ = lane_on ? (-slope2 * (float)(tq - (j * MB_BS + (KT) * 64)) - m_run) : -INFINITY; f32x16 cin_; \
                        _Pragma("unroll") for (int r = 0; r < 16; ++r) cin_[r] = nb_; \
                        MB_PRIO(1); P0 = mfma32(abias0, qones, cin_); P1 = mfma32(abias1, qones, cin_); \
                        _Pragma("unroll") for (int d0 = 0; d0 < 4; ++d0) { P0 = mfma32(kf[2 * d0], qr[d0], P0); P1 = mfma32(kf[2 * d0 + 1], qr[d0], P1); } MB_PRIO(0); } while (0)
                    bf16x8 kf[8];
                    f32x16 p0, p1;
#define MB_TILE(KT) do { const int kt = (KT); const int kpos0 = j * MB_BS + kt * 64; const bool more = kt + 1 < ntile; \
                        if (MB_SWAP && wave >= 4 && kt == MB_SWAP) __builtin_amdgcn_s_setprio(1);     \
                        const LAS unsigned char* vbp = Vb0 + kt * 8192; s16x4 vlo[8], vhh[8];     \
                        _Pragma("unroll") for (int d0 = 0; d0 < 2; ++d0) _Pragma("unroll") for (int ks = 0; ks < 4; ++ks) { \
                            vlo[d0 * 4 + ks] = __builtin_bit_cast(s16x4, __builtin_amdgcn_ds_read_tr16_b64_v4i16((LAS v4i16_t*)(vbp + d0 * 4096 + ks * 1024))); \
                            vhh[d0 * 4 + ks] = __builtin_bit_cast(s16x4, __builtin_amdgcn_ds_read_tr16_b64_v4i16((LAS v4i16_t*)(vbp + d0 * 4096 + ks * 1024 + 512))); } \
                        MB_QK(p0, p1, kt); \
                        __builtin_amdgcn_sched_barrier(0); \
                        if (own && 64 * kt + 63 > 32 * qg) { asm volatile("; causal boundary tile" ::: "memory"); const int dq = tq - kpos0 - 4 * hi; \
                            _Pragma("unroll") for (int r = 0; r < 16; ++r) { if (crow(r, 0) > dq) p0[r] = -INFINITY; if (crow(r, 0) + 32 > dq) p1[r] = -INFINITY; } } \
                        float mxa = __builtin_fmaxf(__builtin_fmaxf(p0[0], p0[1]), p1[0]), mxb = __builtin_fmaxf(__builtin_fmaxf(p0[2], p0[3]), p1[1]); mxa = __builtin_fmaxf(__builtin_fmaxf(mxa, p1[2]), p1[3]); \
                        _Pragma("unroll") for (int r = 4; r < 16; r += 4) { mxa = __builtin_fmaxf(__builtin_fmaxf(mxa, p0[r]), p0[r + 1]); mxb = __builtin_fmaxf(__builtin_fmaxf(mxb, p0[r + 2]), p0[r + 3]); \
                            mxa = __builtin_fmaxf(__builtin_fmaxf(mxa, p1[r]), p1[r + 1]); mxb = __builtin_fmaxf(__builtin_fmaxf(mxb, p1[r + 2]), p1[r + 3]); } \
                        float mx = __builtin_fmaxf(mxa, mxb); { const auto rr_ = __builtin_amdgcn_permlane32_swap(__float_as_uint(mx), __float_as_uint(mx), false, false);     \
                            mx = __builtin_fmaxf(__uint_as_float(rr_[0]), __uint_as_float(rr_[1])); } \
                        if (__any(mx > MB_THR)) { asm volatile("; reference raised" ::: "memory"); \
                            const float dl = __builtin_fmaxf(mx, 0.f); m_run += dl; \
                            if (hi == 0) wsf[r32] = __builtin_amdgcn_exp2f(-dl); \
                            _Pragma("unroll") for (int r = 0; r < 16; ++r) { p0[r] -= dl; p1[r] -= dl; } \
                            asm volatile("s_waitcnt lgkmcnt(0)" ::: "memory"); \
                            _Pragma("unroll") for (int r = 0; r < 16; ++r) { const float f = wsf[crow(r, hi)]; o[0][r] *= f; o[1][r] *= f; o2[r] *= f; } } \
                        _Pragma("unroll") for (int r = 0; r < 16; ++r) { p0[r] = __builtin_amdgcn_exp2f(p0[r]); p1[r] = __builtin_amdgcn_exp2f(p1[r]); } \
                        v4u pw0, pw1, pw2, pw3; \
                        pw0 = (v4u){pkbf(p0[0], p0[1]), pkbf(p0[2], p0[3]), pkbf(p0[4], p0[5]), pkbf(p0[6], p0[7])}; \
                        pw1 = (v4u){pkbf(p0[8], p0[9]), pkbf(p0[10], p0[11]), pkbf(p0[12], p0[13]), pkbf(p0[14], p0[15])}; \
                        pw2 = (v4u){pkbf(p1[0], p1[1]), pkbf(p1[2], p1[3]), pkbf(p1[4], p1[5]), pkbf(p1[6], p1[7])}; \
                        pw3 = (v4u){pkbf(p1[8], p1[9]), pkbf(p1[10], p1[11]), pkbf(p1[12], p1[13]), pkbf(p1[14], p1[15])}; \
                        __builtin_amdgcn_sched_barrier(0); \
                        MB_KLOAD(more ? kt + 1 : kt);     \
                        MB_PRIO(1); \
                        o2 = mfma32(__builtin_bit_cast(bf16x8, pw0), vones, o2); o2 = mfma32(__builtin_bit_cast(bf16x8, pw1), vones, o2); \
                        o2 = mfma32(__builtin_bit_cast(bf16x8, pw2), vones, o2); o2 = mfma32(__builtin_bit_cast(bf16x8, pw3), vones, o2); \
                        _Pragma("unroll") for (int d0 = 0; d0 < 2; ++d0) { \
                            o[d0] = mfma32(__builtin_bit_cast(bf16x8, pw0), MB_PK(d0 * 4 + 0), o[d0]); \
                            o[d0] = mfma32(__builtin_bit_cast(bf16x8, pw1), MB_PK(d0 * 4 + 1), o[d0]); \
                            o[d0] = mfma32(__builtin_bit_cast(bf16x8, pw2), MB_PK(d0 * 4 + 2), o[d0]); \
                            o[d0] = mfma32(__builtin_bit_cast(bf16x8, pw3), MB_PK(d0 * 4 + 3), o[d0]); } \
                        MB_PRIO(0); __builtin_amdgcn_sched_barrier(0); } while (0)
#define MB_PK(k) (bf16x8){vlo[k][0], vlo[k][1], vlo[k][2], vlo[k][3], vhh[k][0], vhh[k][1], vhh[k][2], vhh[k][3]}
                    MB_KLOAD(0);
                    __builtin_amdgcn_sched_barrier(0);
#pragma unroll 1
                    for (int kt1 = 0; kt1 < ntile; ++kt1) { MB_TILE(kt1); }
                    if (MB_SWAP && wave >= 4) __builtin_amdgcn_s_setprio(0);
#undef MB_PK
#undef MB_TILE
#undef MB_KLOAD
#undef MB_QK
                }
            }
#if defined(PROBE_MT)
            { const unsigned long long n_ = __builtin_amdgcn_s_memrealtime(); mt_comp += n_ - mt_prev; mt_prev = n_; }
#endif
            if (okn) { MB_ULOAD(bhn, qbn); }
            asm volatile("s_waitcnt lgkmcnt(0)" ::: "memory"); __builtin_amdgcn_s_barrier(); asm volatile("" ::: "memory");
            LAS bf16* stg = (LAS bf16*)(ldsb + ((par + nblk - 1) & 1) * MBL_BUF) + wave * 2048;
#pragma unroll
            for (int r = 0; r < 16; ++r) { const int orow = crow(r, hi);
                const float la = __uint_as_float(__builtin_amdgcn_readlane(__float_as_uint(o2[r]), 0)), lb = __uint_as_float(__builtin_amdgcn_readlane(__float_as_uint(o2[r]), 32)); const float rl = __builtin_amdgcn_rcpf(hi ? lb : la);
                stg[orow * 64 + r32] = (bf16)f2bf(o[0][r] * rl); stg[orow * 64 + 32 + r32] = (bf16)f2bf(o[1][r] * rl); }
            asm volatile("s_waitcnt lgkmcnt(0)" ::: "memory");
            bf16* Ow = (bf16*)(ws + out_off) + ((size_t)b * SEQ + qb * MB_BS + qg * 32) * opitch + ocol + h * MB_D;
#pragma unroll
            for (int i = 0; i < 4; ++i) { const int row = i * 8 + (lane >> 3), ch = lane & 7; const v4u v = *(const LAS v4u*)(stg + row * 64 + ch * 8); *(v4u*)(Ow + (size_t)row * opitch + ch * 8) = v; }
            par = (par + nblk) & 1;
#if defined(PROBE_MT)
            { const unsigned long long n_ = __builtin_amdgcn_s_memrealtime(); mt_epi += n_ - mt_prev;
              if (lane == 0) { LAS unsigned long long* MTA = (LAS unsigned long long*)(ldsb + LDSCTL_OFF + 14336) + wave * 4; MTA[0] += mt_pro; MTA[1] += mt_comp; MTA[2] += mt_wait; MTA[3] += mt_epi; } }
#endif
        }
    }
    asm volatile("s_waitcnt vmcnt(0) lgkmcnt(0)" ::: "memory"); __builtin_amdgcn_s_barrier(); asm volatile("" ::: "memory");
#undef MB_DMA2
#undef MB_ULOAD
#undef MB_UNIT
}

#ifndef HGRN_NAIVE
#define HGRN_NAIVE 0
#endif
#ifndef MOBA_NAIVE
#define MOBA_NAIVE 0
#endif
#ifndef PROBE_GEMM
#define PROBE_GEMM 1
#endif
#ifndef PROBE_G0
#define PROBE_G0 PROBE_GEMM
#endif
#ifndef PROBE_G1
#define PROBE_G1 PROBE_GEMM
#endif
#ifndef PROBE_G2
#define PROBE_G2 PROBE_GEMM
#endif
#ifndef PROBE_G3
#define PROBE_G3 PROBE_GEMM
#endif
#ifndef PROBE_G4
#define PROBE_G4 PROBE_GEMM
#endif
#ifndef PROBE_G5
#define PROBE_G5 PROBE_GEMM
#endif
#ifndef PROBE_G6
#define PROBE_G6 PROBE_GEMM
#endif
#ifndef PROBE_G7
#define PROBE_G7 PROBE_GEMM
#endif
#ifndef GEMM_ALIGN
#define GEMM_ALIGN true
#endif
#ifndef GEMM_SP2
#define GEMM_SP2 true
#endif
#ifndef PROBE_NOATOM
#define PROBE_NOATOM 0
#endif
#ifndef PROBE_NOSUM
#define PROBE_NOSUM 0
#endif
#ifndef PROBE_DUMMY
#define PROBE_DUMMY 0
#endif
#ifndef PROBE_KM
#define PROBE_KM 1
#endif
#ifndef PROBE_BAR
#define PROBE_BAR 0
#endif
#ifndef PROBE_NORM
#define PROBE_NORM 1
#endif
#ifndef PROBE_HGAB
#define PROBE_HGAB 1
#endif
#ifndef PROBE_SEL
#define PROBE_SEL 1
#endif
#ifndef PROBE_CVT
#define PROBE_CVT 1
#endif
#ifndef PROBE_ATTN
#define PROBE_ATTN 1
#endif
#ifndef PROBE_HGC
#define PROBE_HGC 1
#endif
struct Args { const float* in[15]; float* out; unsigned char* ws; };
__global__ void __launch_bounds__(NWAVES * 64, 2) fwd_kernel(Args args) {
    extern __shared__ __attribute__((aligned(16))) unsigned char lds[];
    Frame F;
    F.lds = (LAS unsigned char*)lds;
    F.MISC = (volatile LAS unsigned*)(F.lds + MISC_OFF);
    F.tid = threadIdx.x; F.lane = F.tid & 63; F.wave = __builtin_amdgcn_readfirstlane(F.tid >> 6);
    F.G = gridDim.x; F.ws = args.ws; F.xo = args.out;
    F.ctl = (gu32*)(args.ws + WS_CTL);
    for (int u = F.tid; u < (LDS_BYTES - LDSCTL_OFF) / 4; u += NWAVES * 64) ((LAS unsigned*)(F.lds + LDSCTL_OFF))[u] = 0u;
    __syncthreads();
    XcdBarrier bar = xcd_barrier_post((unsigned*)(F.ctl + CW_BAR), F.MISC + 8);
#define GRID_BAR() xcd_barrier(bar)
#define GRID_BAR_TS(id) do { TS(id); xcd_barrier(bar); TS(8); } while (0)
    unsigned char* ws = args.ws;
    bf16* Hb = (bf16*)(ws + WS_H);
    bf16* BIG = (bf16*)(ws + WS_BIG);
    bf16* MRG = (bf16*)F.xo;
    const bf16* wb = (const bf16*)(ws + WS_W);
    compute_lb(F, args.in[6]);
#if defined(PROBE_TS)
    LAS unsigned long long* TSA = (LAS unsigned long long*)(F.lds + LDSCTL_OFF + 13568);
    if (blockIdx.x == 0 && threadIdx.x == 0) { for (int i_ = 0; i_ < 16; ++i_) TSA[i_] = 0ull; TSA[0] = wall_clock64(); }
#define TS(id) do { if (blockIdx.x == 0 && threadIdx.x == 0) { const unsigned long long n_ = wall_clock64(); TSA[1 + (id)] += n_ - TSA[0]; TSA[0] = n_; } } while (0)
#else
#define TS(id) do { } while (0)
#endif
    unsigned long long* SS = (unsigned long long*)(ws + WS_SS);
    LAS float* RACC = (LAS float*)(F.lds + LDSCTL_OFF + 4096); LAS unsigned* RCNT = (LAS unsigned*)(F.lds + LDSCTL_OFF + 4096 + 4096);
#define GEMM_REP(n) _Pragma("nounroll") for (int rep_ = 0; rep_ < (n); ++rep_)

#pragma nounroll
    for (int l = 0; l < DEPTH; ++l) {
        unsigned long long* ss1 = SS + (size_t)(3 * l + 0) * MROWS; unsigned long long* ss2 = SS + (size_t)(3 * l + 1) * MROWS; unsigned long long* ss3 = SS + (size_t)(3 * l + 2) * MROWS; unsigned long long* ss4 = SS + (size_t)(3 * l + 3) * MROWS;
        _Pragma("nounroll") for (int rep_ = 0; rep_ < PROBE_CVT; ++rep_) phase_convert(F, args.in, l);
        if (l == 0) { _Pragma("nounroll") for (int rep_ = 0; rep_ < PROBE_NORM; ++rep_) phase_xb_ss(F, args.in[0], Hb, ss1); }
        GRID_BAR_TS(0);
#if defined(PROBE_NULLEPI)
#ifndef PROBE_SCHED
#define PROBE_SCHED pg8::StaticOrderC
#endif
        { pg8::Gemm g{Hb, (const bf16*)((const unsigned char*)wb + W_GU1), MROWS, 2 * DFF, DM, DM}; PROBE_SCHED<MROWS, 2 * DFF> S; S.init(F.G, (int)blockIdx.x);
          pg8::EpiNull E{(float*)(ws + WS_END)};
          pg8::gemm_phase<pg8::EpiNull, PROBE_SCHED<MROWS, 2 * DFF>, GEMM_ALIGN, GEMM_SP2, PROBE_NULLEPI, PROBE_NULLEPI, true>(F.lds + RING_OFF, g, S, E); }
#endif
        GEMM_REP(PROBE_G0)
        { pg8::Gemm g{Hb, (const bf16*)((const unsigned char*)wb + W_GU1), MROWS, 2 * DFF, DM, DM}; pg8::StaticOrderC<MROWS, 2 * DFF> S; S.init(F.G, (int)blockIdx.x);
          pg8::EpiSwiGLU E{BIG, DFF, ss1, (PROBE_DUMMY && rep_ + 1 < PROBE_G0) ? ws + WS_END : nullptr};
          pg8::gemm_phase<pg8::EpiSwiGLU, pg8::StaticOrderC<MROWS, 2 * DFF>, GEMM_ALIGN, GEMM_SP2, DM, DM, true>(F.lds + RING_OFF, g, S, E); }
        GRID_BAR_TS(1);
#if defined(PROBE_KDN)
        { pg8::Gemm g{BIG, (const bf16*)((const unsigned char*)wb + W_DN1), MROWS, DM, PROBE_KDN, PROBE_KDN}; pg8::StaticOrderC<MROWS, DM> S; S.init(F.G, (int)blockIdx.x);
          pg8::EpiResid E{Hb, DM, 0.0f, SS + (size_t)7 * MROWS, RACC, RCNT, false};
          pg8::gemm_phase<pg8::EpiResid, pg8::StaticOrderC<MROWS, DM>, GEMM_ALIGN, GEMM_SP2, PROBE_KDN, PROBE_KDN, true>(F.lds + RING_OFF, g, S, E); }
#endif
        GEMM_REP(PROBE_G1)
        { pg8::Gemm g{BIG, (const bf16*)((const unsigned char*)wb + W_DN1), MROWS, DM, DFF, DFF}; pg8::StaticOrderC<MROWS, DM> S; S.init(F.G, (int)blockIdx.x);
          pg8::EpiResid E{Hb, DM, (rep_ + 1 < PROBE_G1) ? 0.0f : 0.5f, (rep_ + 1 < PROBE_G1) ? (PROBE_NOATOM ? nullptr : SS + (size_t)7 * MROWS) : ss2, RACC, RCNT, false};
          pg8::gemm_phase<pg8::EpiResid, pg8::StaticOrderC<MROWS, DM>, GEMM_ALIGN, GEMM_SP2, DFF, DFF, true>(F.lds + RING_OFF, g, S, E); }
        GRID_BAR_TS(2);
        GEMM_REP(PROBE_G2)
        { pg8::Gemm g{Hb, (const bf16*)((const unsigned char*)wb + W_IN), MROWS, DIN, DM, DM}; pg8::StaticOrderC<MROWS, DIN> S; S.init(F.G, (int)blockIdx.x);
          pg8::EpiStoreBf16 E{(unsigned char*)BIG, C_MQ / 256, C_MK / 256, MB_C2, ss2, C_MK / 256, C_MV / 256, (unsigned char*)F.xo + KIMG_OFF, (unsigned char*)F.xo + VIMG_OFF, SEQ};
          pg8::gemm_phase<pg8::EpiStoreBf16, pg8::StaticOrderC<MROWS, DIN>, GEMM_ALIGN, GEMM_SP2, DM, DM, true>(F.lds + RING_OFF, g, S, E); }
        GRID_BAR_TS(3);
        _Pragma("nounroll") for (int rep_ = 0; rep_ < PROBE_KM; ++rep_) phase_kmean(F);
        _Pragma("nounroll") for (int rep_ = 0; rep_ < PROBE_BAR; ++rep_) GRID_BAR();
        _Pragma("nounroll") for (int rep_ = 0; rep_ < PROBE_HGAB; ++rep_) {
        phase_hgrn_A(F, l);
        GRID_BAR_TS(4);
        phase_hgrn_B(F);
        if (rep_ + 1 == PROBE_HGAB) { _Pragma("nounroll") for (int rep2_ = 0; rep2_ < PROBE_SEL; ++rep2_) phase_moba_select(F); }
        GRID_BAR_TS(5);
        }
#if PROBE_ATTN > 1
        phase_moba_attn(F, WS_END, 512, 0);
#endif
        phase_moba_attn(F, WS_BIG + BIG_OAB, DM, 512);
        TS(6);
#if PROBE_HGC > 1
        phase_hgrn_C(F, l, args.in[7] + l * HG_D, WS_END, 512, 0);
#endif
        phase_hgrn_C(F, l, args.in[7] + l * HG_D, WS_BIG + BIG_OAB, DM, 0);
        GRID_BAR_TS(7);
        GEMM_REP(PROBE_G3)
        { const bf16* OAB = (const bf16*)((const unsigned char*)BIG + BIG_OAB);
          pg8::Gemm g{OAB, (const bf16*)((const unsigned char*)wb + W_A), MROWS, DM, DM, DM}; pg8::StaticOrderC<MROWS, DM> S; S.init(F.G, (int)blockIdx.x);
          pg8::EpiGateMerge E{(const unsigned char*)BIG + BIG_GIMG, MRG, DM};
          pg8::gemm_phase<pg8::EpiGateMerge, pg8::StaticOrderC<MROWS, DM>, GEMM_ALIGN, GEMM_SP2, DM, DM>(F.lds + RING_OFF, g, S, E); }
        GRID_BAR_TS(9);
        GEMM_REP(PROBE_G5)
        { pg8::Gemm g{MRG, (const bf16*)((const unsigned char*)wb + W_OUT), MROWS, DM, DM, DM}; pg8::StaticOrderC<MROWS, DM> S; S.init(F.G, (int)blockIdx.x);
          pg8::EpiResid E{Hb, DM, (rep_ + 1 < PROBE_G5) ? 0.0f : 1.0f, (rep_ + 1 < PROBE_G5) ? SS + (size_t)7 * MROWS : ss3, RACC, RCNT, (PROBE_NOSUM && rep_ + 1 < PROBE_G5)};
          pg8::gemm_phase<pg8::EpiResid, pg8::StaticOrderC<MROWS, DM>, GEMM_ALIGN, GEMM_SP2, DM, DM, true>(F.lds + RING_OFF, g, S, E); }
        GRID_BAR_TS(10);
        GEMM_REP(PROBE_G6)
        { pg8::Gemm g{Hb, (const bf16*)((const unsigned char*)wb + W_GU2), MROWS, 2 * DFF, DM, DM}; pg8::StaticOrderC<MROWS, 2 * DFF> S; S.init(F.G, (int)blockIdx.x);
          pg8::EpiSwiGLU E{BIG, DFF, ss3, nullptr};
          pg8::gemm_phase<pg8::EpiSwiGLU, pg8::StaticOrderC<MROWS, 2 * DFF>, GEMM_ALIGN, GEMM_SP2, DM, DM, true>(F.lds + RING_OFF, g, S, E); }
        GRID_BAR_TS(1);
        GEMM_REP(PROBE_G7)
        { pg8::Gemm g{BIG, (const bf16*)((const unsigned char*)wb + W_DN2), MROWS, DM, DFF, DFF}; pg8::StaticOrderC<MROWS, DM> S; S.init(F.G, (int)blockIdx.x);
          pg8::EpiResid E{Hb, DM, (rep_ + 1 < PROBE_G7) ? 0.0f : 0.5f, (rep_ + 1 < PROBE_G7) ? SS + (size_t)7 * MROWS : ss4, RACC, RCNT, false};
          pg8::gemm_phase<pg8::EpiResid, pg8::StaticOrderC<MROWS, DM>, GEMM_ALIGN, GEMM_SP2, DFF, DFF, true>(F.lds + RING_OFF, g, S, E); }
        GRID_BAR_TS(2);
    }
#if defined(PROBE_TS)
    if (blockIdx.x == 0 && threadIdx.x == 0) ((float*)(ws + WS_LB))[4000] = floorf((float)TSA[1 + PROBE_TS] * 0.01f * (1.0f / PROBE_TS_UNIT) * PROBE_TS_Q + 0.5f) * (1.0f / PROBE_TS_Q);
    GRID_BAR();
#endif
#if defined(PROBE_HT)
    if (blockIdx.x == 0) { __syncthreads(); if (threadIdx.x == 0) {
        const unsigned long long q_ = ((LAS unsigned long long*)(F.lds + LDSCTL_OFF + 14336 + 256))[PROBE_HT]; const unsigned long long t0_ = __builtin_amdgcn_s_memrealtime();
        while (__builtin_amdgcn_s_memrealtime() - t0_ < q_ * PROBE_HT_K) __builtin_amdgcn_s_sleep(8); } __syncthreads(); }
#endif
#if defined(PROBE_MT)
    if (blockIdx.x == 0) { __syncthreads(); if (threadIdx.x == 0) {
        const LAS unsigned long long* mta_ = (LAS unsigned long long*)(F.lds + LDSCTL_OFF + 14336) + PROBE_MT_WAVE * 4; const unsigned long long q_ = (PROBE_MT >= 4) ? mta_[0] + mta_[1] + mta_[2] + mta_[3] : mta_[PROBE_MT & 3]; const unsigned long long t0_ = __builtin_amdgcn_s_memrealtime();
        while (__builtin_amdgcn_s_memrealtime() - t0_ < q_ * PROBE_MT_K) __builtin_amdgcn_s_sleep(8); } __syncthreads(); }
#endif
    phase_final_norm(F, Hb, F.xo, args.in[14], SS + (size_t)(3 * DEPTH) * MROWS);
}

extern "C" void kernel_launch(void* const* d_in, const int* in_sizes, int n_in, void* d_out, int out_size, void* d_ws, size_t ws_size, hipStream_t stream) {
    static int grid = 0;
    if (grid == 0) {
        if (n_in != 15 || in_sizes[0] != MROWS * DM || out_size != MROWS * DM || ws_size < WS_END + ((PROBE_ATTN > 1 || PROBE_HGC > 1) ? 32 * MiB : 0)) { fprintf(stderr, "kernel_launch: unexpected shapes (n_in %d, in0 %d, out %d, ws %zu; need ws >= %zu); nothing launched\n", n_in, n_in > 0 ? in_sizes[0] : -1, out_size, ws_size, (size_t)WS_END); grid = -1; return; }
        int dev = 0, cus = 0, per_cu = 0;
        if (hipGetDevice(&dev) != hipSuccess || hipDeviceGetAttribute(&cus, hipDeviceAttributeMultiprocessorCount, dev) != hipSuccess) { grid = -1; return; }
        if (hipFuncSetAttribute((const void*)fwd_kernel, hipFuncAttributeMaxDynamicSharedMemorySize, LDS_BYTES) != hipSuccess) { fprintf(stderr, "kernel_launch: hipFuncSetAttribute failed\n"); grid = -1; return; }
        if (hipOccupancyMaxActiveBlocksPerMultiprocessor(&per_cu, (const void*)fwd_kernel, NWAVES * 64, LDS_BYTES) != hipSuccess || per_cu < 1)
            fprintf(stderr, "kernel_launch: note: occupancy query reports %d workgroups per CU\n", per_cu);
        (void)hipGetLastError();
        grid = cus;
    }
    if (grid < 0) return;
    if (hipMemsetAsync((char*)d_ws + WS_CTL, 0, CTL_ZERO_BYTES, stream) != hipSuccess) { fprintf(stderr, "kernel_launch: memset failed\n"); return; }
    Args a{};
    for (int i = 0; i < 15; ++i) a.in[i] = (const float*)d_in[i];
    a.out = (float*)d_out; a.ws = (unsigned char*)d_ws;
    hipLaunchKernelGGL(fwd_kernel, dim3(grid), dim3(NWAVES * 64), LDS_BYTES, stream, a);
}
```
